# Optimizing an MI355X kernel written in HIP

```python
import jax, jax.numpy as jnp
from jax import lax
import numpy as np

D_MODEL = 4096
BATCH = 16
SEQ = 256
DEPTH = 1
DEC_BATCH = 2
DEC_SEQ = 2048
PAST_LEN = 256

GRID_W = 64
HEAD_DIM = 128
N_Q_HEADS = 16
N_KV_HEADS = 4
GQA_GROUP = N_Q_HEADS // N_KV_HEADS
ATTN_WIDTH = N_Q_HEADS * HEAD_DIM
KV_WIDTH = N_KV_HEADS * HEAD_DIM
CONV_WIDTH = D_MODEL - ATTN_WIDTH
CONV_K = 3
IN_WIDTH = ATTN_WIDTH + 2 * KV_WIDTH + 3 * CONV_WIDTH
WINDOW = 128
BLOCK = 128
D_FF = 11008
ROPE_THETA = 10000.0
ROPE_AXIS_DIM = HEAD_DIM // 2
ROPE_PAIRS = ROPE_AXIS_DIM // 2
N_SUB = 3
EPS = 1e-6
NEG = -1e30

kernel_name = "hybrid_swa_shortconv_macaron_dit_step"


def _rmsnorm(x, g):
    xf = x.astype(jnp.float32)
    y = xf * lax.rsqrt(jnp.mean(xf * xf, axis=-1, keepdims=True) + EPS)
    return (y * g.astype(jnp.float32)).astype(x.dtype)


def _swiglu(u, wg, wu, wd):
    return (jax.nn.silu(u @ wg) * (u @ wu)) @ wd


def _modulation(cond, w_mod_l, b_mod_l):
    m = jax.nn.silu(cond) @ w_mod_l + b_mod_l
    return m.reshape(m.shape[0], N_SUB, 3, D_MODEL)[:, :, :, None, :]


def _pre(h, m, s, g_pre):
    return _rmsnorm(h, g_pre) * (1 + m[:, s, 1]) + m[:, s, 0]


def _post(h, o, m, s, g_post, res_w):
    return h + res_w * m[:, s, 2] * _rmsnorm(o, g_post)


def _rotate_axis(xa, pos):
    inv_freq = ROPE_THETA ** (-jnp.arange(ROPE_PAIRS, dtype=jnp.float32) / ROPE_PAIRS)
    ang = pos.astype(jnp.float32)[:, None] * inv_freq[None, :]
    extra = xa.ndim - 3
    ang = ang.reshape(ang.shape[0], *([1] * extra), ROPE_PAIRS)
    cos, sin = jnp.cos(ang), jnp.sin(ang)
    xf = xa.astype(jnp.float32)
    x1, x2 = xf[..., :ROPE_PAIRS], xf[..., ROPE_PAIRS:]
    out = jnp.concatenate([x1 * cos - x2 * sin, x2 * cos + x1 * sin], axis=-1)
    return out.astype(xa.dtype)


def _rope_2d(x):
    T = x.shape[1]
    rows = T // GRID_W
    row_ids = jnp.repeat(jnp.arange(rows), GRID_W)
    col_ids = jnp.tile(jnp.arange(GRID_W), rows)
    return jnp.concatenate([_rotate_axis(x[..., :ROPE_AXIS_DIM], row_ids),
                            _rotate_axis(x[..., ROPE_AXIS_DIM:], col_ids)], axis=-1)


def _attend(q, k, v, mask, sink):
    s = jnp.einsum('bqhgd,bkhd->bhgqk', q, k, preferred_element_type=jnp.float32) * (HEAD_DIM ** -0.5)
    if mask is not None:
        s = jnp.where(mask, s, NEG)
    sink_col = jnp.broadcast_to(sink.astype(jnp.float32).reshape(1, N_KV_HEADS, GQA_GROUP, 1, 1),
                                s.shape[:-1] + (1,))
    p = jax.nn.softmax(jnp.concatenate([s, sink_col], axis=-1), axis=-1)[..., :-1]
    return jnp.einsum('bhgqk,bkhd->bqhgd', p.astype(v.dtype), v)


def _to_blocks(q):
    B, T = q.shape[:2]
    return q.reshape(B, T // BLOCK, BLOCK, N_KV_HEADS, GQA_GROUP, HEAD_DIM).transpose(1, 0, 2, 3, 4, 5)


def _from_blocks(ob):
    nb, B = ob.shape[:2]
    return ob.transpose(1, 0, 2, 3, 4, 5).reshape(B, nb * BLOCK, ATTN_WIDTH)


def _context_attention(q, k, v, sink):
    ob = lax.map(lambda qi: _attend(qi, k, v, None, sink), _to_blocks(q))
    return _from_blocks(ob)


def _latent_attention(q, k, v, k_ctx, v_ctx, sink):
    T = q.shape[1]
    nb = T // BLOCK
    P = k_ctx.shape[1]
    pad = ((0, 0), (BLOCK, BLOCK), (0, 0), (0, 0))
    k_pad, v_pad = jnp.pad(k, pad), jnp.pad(v, pad)
    q_off = jnp.arange(BLOCK)
    k_off = jnp.arange(3 * BLOCK) - BLOCK
    in_window = jnp.abs(k_off[None, :] - q_off[:, None]) <= WINDOW
    ctx_mask = jnp.ones((BLOCK, P), dtype=bool)

    def step(args):
        blk, qi = args
        kw = lax.dynamic_slice_in_dim(k_pad, blk * BLOCK, 3 * BLOCK, axis=1)
        vw = lax.dynamic_slice_in_dim(v_pad, blk * BLOCK, 3 * BLOCK, axis=1)
        key_pos = blk * BLOCK + k_off
        valid = in_window & ((key_pos >= 0) & (key_pos < T))[None, :]
        keys = jnp.concatenate([kw, k_ctx], axis=1)
        vals = jnp.concatenate([vw, v_ctx], axis=1)
        mask = jnp.concatenate([valid, ctx_mask], axis=1)
        return _attend(qi, keys, vals, mask, sink)

    ob = lax.map(step, (jnp.arange(nb), _to_blocks(q)))
    return _from_blocks(ob)


def _project(u, w_in_l):
    B, T = u.shape[:2]
    z = u @ w_in_l
    o1 = ATTN_WIDTH
    o2 = o1 + KV_WIDTH
    o3 = o2 + KV_WIDTH
    o4 = o3 + CONV_WIDTH
    o5 = o4 + CONV_WIDTH
    q = z[..., :o1].reshape(B, T, N_KV_HEADS, GQA_GROUP, HEAD_DIM)
    k = z[..., o1:o2].reshape(B, T, N_KV_HEADS, HEAD_DIM)
    v = z[..., o2:o3].reshape(B, T, N_KV_HEADS, HEAD_DIM)
    return q, k, v, z[..., o3:o4], z[..., o4:o5], z[..., o5:]


def _short_conv(gb, gc, hc, w_conv_l):
    u = gc * hc
    up = jnp.pad(u, ((0, 0), (1, 1), (0, 0)))
    y = up[:, :-2] * w_conv_l[0] + up[:, 1:-1] * w_conv_l[1] + up[:, 2:] * w_conv_l[2]
    return gb * y


def _merge(attn_o, conv_o, g_a, g_c, w_o_l):
    return jnp.concatenate([_rmsnorm(attn_o, g_a), _rmsnorm(conv_o, g_c)], axis=-1) @ w_o_l


def setup_inputs(seed: int = 0) -> dict:
    key = jax.random.key(seed)
    ks = jax.random.split(key, 24)
    f32 = jnp.float32
    nrm = lambda k, shape, s: jax.random.normal(k, shape, f32) * s
    return {
        "x_prompt": nrm(ks[0], (BATCH, SEQ, D_MODEL), 1.0),
        "x_sample": nrm(ks[1], (DEC_BATCH, DEC_SEQ, D_MODEL), 1.0),
        "c": nrm(ks[2], (DEC_BATCH, D_MODEL), 1.0),
        "cache_k": nrm(ks[3], (DEC_BATCH, DEPTH, PAST_LEN, N_KV_HEADS, HEAD_DIM), 1.0),
        "cache_v": nrm(ks[4], (DEC_BATCH, DEPTH, PAST_LEN, N_KV_HEADS, HEAD_DIM), 1.0),
        "c_ctx": nrm(ks[5], (D_MODEL,), 1.0),
        "w_mod": nrm(ks[6], (DEPTH, D_MODEL, N_SUB * 3 * D_MODEL), 0.5 * D_MODEL ** -0.5),
        "b_mod": nrm(ks[7], (DEPTH, N_SUB * 3 * D_MODEL), 0.02),
        "g_pre": 1.0 + nrm(ks[8], (DEPTH, N_SUB, D_MODEL), 0.05),
        "g_post": 1.0 + nrm(ks[9], (DEPTH, N_SUB, D_MODEL), 0.05),
        "w_in": nrm(ks[10], (DEPTH, D_MODEL, IN_WIDTH), D_MODEL ** -0.5),
        "w_conv": nrm(ks[11], (DEPTH, CONV_K, CONV_WIDTH), CONV_K ** -0.5),
        "sink": nrm(ks[12], (DEPTH, N_Q_HEADS), 0.5),
        "g_attn_out": 1.0 + nrm(ks[13], (DEPTH, ATTN_WIDTH), 0.05),
        "g_conv_out": 1.0 + nrm(ks[14], (DEPTH, CONV_WIDTH), 0.05),
        "w_o": nrm(ks[15], (DEPTH, D_MODEL, D_MODEL), D_MODEL ** -0.5),
        "w_ffn1_gate": nrm(ks[16], (DEPTH, D_MODEL, D_FF), D_MODEL ** -0.5),
        "w_ffn1_up": nrm(ks[17], (DEPTH, D_MODEL, D_FF), D_MODEL ** -0.5),
        "w_ffn1_down": nrm(ks[18], (DEPTH, D_FF, D_MODEL), D_FF ** -0.5),
        "w_ffn2_gate": nrm(ks[19], (DEPTH, D_MODEL, D_FF), D_MODEL ** -0.5),
        "w_ffn2_up": nrm(ks[20], (DEPTH, D_MODEL, D_FF), D_MODEL ** -0.5),
        "w_ffn2_down": nrm(ks[21], (DEPTH, D_FF, D_MODEL), D_FF ** -0.5),
    }


def reference(x_prompt, x_sample, c, cache_k, cache_v, c_ctx, w_mod, b_mod, g_pre, g_post,
              w_in, w_conv, sink, g_attn_out, g_conv_out, w_o,
              w_ffn1_gate, w_ffn1_up, w_ffn1_down, w_ffn2_gate, w_ffn2_up, w_ffn2_down):
    h = x_prompt
    ks_new, vs_new = [], []
    for l in range(DEPTH):
        m = _modulation(c_ctx[None, :], w_mod[l], b_mod[l])
        o = _swiglu(_pre(h, m, 0, g_pre[l, 0]), w_ffn1_gate[l], w_ffn1_up[l], w_ffn1_down[l])
        h = _post(h, o, m, 0, g_post[l, 0], 0.5)
        q, k, v, gb, gc, hc = _project(_pre(h, m, 1, g_pre[l, 1]), w_in[l])
        attn_o = _context_attention(q, k, v, sink[l])
        conv_o = _short_conv(gb, gc, hc, w_conv[l])
        o = _merge(attn_o, conv_o, g_attn_out[l], g_conv_out[l], w_o[l])
        h = _post(h, o, m, 1, g_post[l, 1], 1.0)
        o = _swiglu(_pre(h, m, 2, g_pre[l, 2]), w_ffn2_gate[l], w_ffn2_up[l], w_ffn2_down[l])
        h = _post(h, o, m, 2, g_post[l, 2], 0.5)
        ks_new.append(k)
        vs_new.append(v)
    y_prompt = h
    state_k = jnp.stack(ks_new, axis=1)
    state_v = jnp.stack(vs_new, axis=1)

    h = x_sample
    for l in range(DEPTH):
        m = _modulation(c, w_mod[l], b_mod[l])
        o = _swiglu(_pre(h, m, 0, g_pre[l, 0]), w_ffn1_gate[l], w_ffn1_up[l], w_ffn1_down[l])
        h = _post(h, o, m, 0, g_post[l, 0], 0.5)
        q, k, v, gb, gc, hc = _project(_pre(h, m, 1, g_pre[l, 1]), w_in[l])
        q, k = _rope_2d(q), _rope_2d(k)
        attn_o = _latent_attention(q, k, v, cache_k[:, l], cache_v[:, l], sink[l])
        conv_o = _short_conv(gb, gc, hc, w_conv[l])
        o = _merge(attn_o, conv_o, g_attn_out[l], g_conv_out[l], w_o[l])
        h = _post(h, o, m, 1, g_post[l, 1], 1.0)
        o = _swiglu(_pre(h, m, 2, g_pre[l, 2]), w_ffn2_gate[l], w_ffn2_up[l], w_ffn2_down[l])
        h = _post(h, o, m, 2, g_post[l, 2], 0.5)
    y_sample = h
    return (y_prompt, y_sample, state_k, state_v)
```

```cpp
#include <hip/hip_runtime.h>
#include <cstdio>
#include <cstdint>
#define MK_N_LAUNCHES 1
namespace pg8 {
#define PG8_LAS __attribute__((address_space(3)))
typedef unsigned short bf16_t;
typedef short bf16x8 __attribute__((ext_vector_type(8)));
typedef float f32x4 __attribute__((ext_vector_type(4)));
typedef unsigned u32x4 __attribute__((ext_vector_type(4)));
constexpr int BM = 256, BK = 64, HALF = 128, HTB = HALF * BK * 2  , STAGE_BYTES = 8 * HTB, NXCD = 8, WGM = 8;

__host__ __device__ __forceinline__ int lds_byte(int r, int c) { const int st = (r >> 4) * 2 + (c >> 5), rr = r & 15, cc = c & 31, ob = rr * 64 + cc * 2; return st * 1024 + (ob ^ (((ob >> 9) & 1) << 5)); }
__host__ __device__ __forceinline__ void stage_rc(int b, int& R, int& C) { const int st = b / 1024, sb = b % 1024, swz = sb ^ (((sb >> 9) & 1) << 5); R = (st >> 1) * 16 + swz / 64; C = (st & 1) * 32 + (swz % 64) / 2; }
__host__ __device__ __forceinline__ int perm32(int rho) { const int n = rho >> 4, i = rho & 15; return 8 * (i >> 2) + 4 * n + (i & 3); }

struct Unit { int pm, pn; };
struct Gemm { const bf16_t* A; const bf16_t* Bt; int M, N, K; };

struct StaticOrder {
    int nM, nN, nwg, G, c;
    __host__ __device__ void init(int M, int N, int G_, int c_) { nM = M / BM; nN = N / BM; nwg = nM * nN; G = G_; c = c_; }
    __host__ __device__ bool next(int i, Unit& u) const {
        const long L = (long)i * G + c; if (L >= nwg) return false;
        int wgid = (int)L; { const int q = nwg / NXCD, r = nwg % NXCD, xcd = wgid % NXCD, off = wgid / NXCD; wgid = (xcd < r ? xcd * (q + 1) : r * (q + 1) + (xcd - r) * q) + off; }
        const int nig = WGM * nN, gid = wgid / nig, fm = gid * WGM, gsz = (nM - fm) < WGM ? (nM - fm) : WGM;
        u.pm = fm + ((wgid % nig) % gsz); u.pn = (wgid % nig) / gsz; return true;
    }
    __device__ __forceinline__ void a_ready(const Unit&) const {}
    __device__ __forceinline__ void done(const Unit&) const {}
};

struct HalfMOrder : StaticOrder {
    __host__ __device__ bool next(int i, Unit& u) const {
        if (!(nM == 32 && nN == 16 && G == 256)) return StaticOrder::next(i, u);
        if (i >= 2) return false;
        const int xcd = c & 7, slot = c >> 3;
        u.pm = 16 * i + 8 * (xcd >> 2) + (slot & 7); u.pn = 4 * (xcd & 3) + (slot >> 3); return true;
    }
};

__device__ __forceinline__ unsigned cvt_pk_bf16(float lo, float hi) { unsigned r; asm volatile("v_cvt_pk_bf16_f32 %0, %1, %2" : "=v"(r) : "v"(lo), "v"(hi)); return r; }
__device__ __forceinline__ float silu_f(float x) { return x * __builtin_amdgcn_rcpf(1.0f + __builtin_amdgcn_exp2f(-1.4426950408889634f * x)); }

struct EpiBf16 {
    static constexpr bool PERM = true, AFTER_DRAIN = false;
    bf16_t* O; int ldc;
    __device__ __forceinline__ void operator()(const f32x4 (&acc)[2][2][4][2], const Unit& u, int wr, int wc, int fr, int fq) const {
        const int row0 = u.pm * BM + wr * 64 + fr, col0 = u.pn * BM + wc * 32 + 8 * fq;
#pragma unroll
        for (int ai = 0; ai < 2; ++ai)
#pragma unroll
            for (int m = 0; m < 4; ++m) { bf16_t* rowp = O + (size_t)(row0 + ai * HALF + m * 16) * ldc + col0;
#pragma unroll
                for (int bj = 0; bj < 2; ++bj) { const f32x4 v0 = acc[ai][bj][m][0], v1 = acc[ai][bj][m][1];
                    u32x4 w; w.x = cvt_pk_bf16(v0[0], v0[1]); w.y = cvt_pk_bf16(v0[2], v0[3]); w.z = cvt_pk_bf16(v1[0], v1[1]); w.w = cvt_pk_bf16(v1[2], v1[3]);
                    *(u32x4*)(rowp + bj * HALF) = w; } }
    }
};
struct EpiSwiGLU {
    static constexpr bool PERM = true, AFTER_DRAIN = false;
    bf16_t* O; int kt_out;
    __device__ __forceinline__ void operator()(const f32x4 (&acc)[2][2][4][2], const Unit& u, int wr, int wc, int fr, int fq) const {
        const int r0 = wr * 64 + fr, col0 = u.pn * HALF + wc * 32 + 8 * fq;
        bf16_t* base = O + ((size_t)u.pm * kt_out + (col0 >> 6)) * 16384 + (col0 & 63);
#pragma unroll
        for (int ai = 0; ai < 2; ++ai)
#pragma unroll
            for (int m = 0; m < 4; ++m) { bf16_t* rowp = base + (r0 + ai * HALF + m * 16) * 64;
                const f32x4 g0 = acc[ai][0][m][0], g1 = acc[ai][0][m][1], u0 = acc[ai][1][m][0], u1 = acc[ai][1][m][1];
                u32x4 w;
                w.x = cvt_pk_bf16(silu_f(g0[0]) * u0[0], silu_f(g0[1]) * u0[1]); w.y = cvt_pk_bf16(silu_f(g0[2]) * u0[2], silu_f(g0[3]) * u0[3]);
                w.z = cvt_pk_bf16(silu_f(g1[0]) * u1[0], silu_f(g1[1]) * u1[1]); w.w = cvt_pk_bf16(silu_f(g1[2]) * u1[2], silu_f(g1[3]) * u1[3]);
                *(u32x4*)rowp = w; }
    }
};
struct EpiInProj {
    static constexpr bool PERM = true, AFTER_DRAIN = false;
    bf16_t* Z; const float* rope; float* state_k; float* state_v;
    __device__ __forceinline__ void operator()(const f32x4 (&acc)[2][2][4][2], const Unit& u, int wr, int wc, int fr, int fq) const {
        const int row0 = u.pm * BM + wr * 64 + fr;
        if (u.pn < 10) {
            const bool isk = u.pn >= 8; const int rb = isk ? 2048 : 0, tl = isk ? u.pn - 8 : u.pn;
            const int hh = wc >> 1, axis = wc & 1, i0 = 8 * fq;
            const int ncol = rb + (2 * tl + hh) * 128 + 64 * axis + i0;
            const bool lat = u.pm >= 16;
#pragma unroll
            for (int ai = 0; ai < 2; ++ai)
#pragma unroll
                for (int m = 0; m < 4; ++m) { const int row = row0 + ai * HALF + m * 16;
                    f32x4 a0 = acc[ai][0][m][0], a1 = acc[ai][0][m][1], b0 = acc[ai][1][m][0], b1 = acc[ai][1][m][1];
                    if (lat) { const int t = (row - 4096) & 2047, pos = axis ? (t & 63) : (t >> 6);
                        const f32x4* tp = (const f32x4*)(rope + ((size_t)pos * 32 + i0) * 2);
                        const f32x4 c01 = tp[0], c23 = tp[1], c45 = tp[2], c67 = tp[3];
                        f32x4 r0, r1, s0, s1;
                        r0[0] = a0[0] * c01[0] - b0[0] * c01[1]; s0[0] = b0[0] * c01[0] + a0[0] * c01[1];
                        r0[1] = a0[1] * c01[2] - b0[1] * c01[3]; s0[1] = b0[1] * c01[2] + a0[1] * c01[3];
                        r0[2] = a0[2] * c23[0] - b0[2] * c23[1]; s0[2] = b0[2] * c23[0] + a0[2] * c23[1];
                        r0[3] = a0[3] * c23[2] - b0[3] * c23[3]; s0[3] = b0[3] * c23[2] + a0[3] * c23[3];
                        r1[0] = a1[0] * c45[0] - b1[0] * c45[1]; s1[0] = b1[0] * c45[0] + a1[0] * c45[1];
                        r1[1] = a1[1] * c45[2] - b1[1] * c45[3]; s1[1] = b1[1] * c45[2] + a1[1] * c45[3];
                        r1[2] = a1[2] * c67[0] - b1[2] * c67[1]; s1[2] = b1[2] * c67[0] + a1[2] * c67[1];
                        r1[3] = a1[3] * c67[2] - b1[3] * c67[3]; s1[3] = b1[3] * c67[2] + a1[3] * c67[3];
                        a0 = r0; a1 = r1; b0 = s0; b1 = s1; }
                    bf16_t* zp = Z + (size_t)row * 9216 + ncol;
                    u32x4 w1, w2; w1.x = cvt_pk_bf16(a0[0], a0[1]); w1.y = cvt_pk_bf16(a0[2], a0[3]); w1.z = cvt_pk_bf16(a1[0], a1[1]); w1.w = cvt_pk_bf16(a1[2], a1[3]);
                    w2.x = cvt_pk_bf16(b0[0], b0[1]); w2.y = cvt_pk_bf16(b0[2], b0[3]); w2.z = cvt_pk_bf16(b1[0], b1[1]); w2.w = cvt_pk_bf16(b1[2], b1[3]);
                    *(u32x4*)zp = w1; *(u32x4*)(zp + 32) = w2;
                    if (isk && !lat) { float* sp = state_k + (size_t)row * 512 + (ncol - 2048);
                        *(f32x4*)sp = a0; *(f32x4*)(sp + 4) = a1; *(f32x4*)(sp + 32) = b0; *(f32x4*)(sp + 36) = b1; } }
        } else {
            const int col0 = u.pn * BM + wc * 32 + 8 * fq; const bool isv = u.pn < 12, ctx = u.pm < 16;
#pragma unroll
            for (int ai = 0; ai < 2; ++ai)
#pragma unroll
                for (int m = 0; m < 4; ++m) { const int row = row0 + ai * HALF + m * 16; bf16_t* zp = Z + (size_t)row * 9216 + col0;
#pragma unroll
                    for (int bj = 0; bj < 2; ++bj) { const f32x4 v0 = acc[ai][bj][m][0], v1 = acc[ai][bj][m][1];
                        u32x4 w; w.x = cvt_pk_bf16(v0[0], v0[1]); w.y = cvt_pk_bf16(v0[2], v0[3]); w.z = cvt_pk_bf16(v1[0], v1[1]); w.w = cvt_pk_bf16(v1[2], v1[3]);
                        *(u32x4*)(zp + bj * HALF) = w;
                        if (isv && ctx) { float* sp = state_v + (size_t)row * 512 + (col0 - 2560) + bj * HALF; *(f32x4*)sp = v0; *(f32x4*)(sp + 4) = v1; } } }
        }
    }
};

template <class Epi, class Sched, bool ALIGN_EPI = false, bool SP2 = false, bool TA = false, bool TB = false>
__device__ __forceinline__ void gemm_phase(PG8_LAS unsigned char* lds, const Gemm g, const Sched& S, const Epi& E) {
    const int tid = threadIdx.x, wid = __builtin_amdgcn_readfirstlane(tid >> 6), lane = tid & 63, wr = wid >> 2, wc = wid & 3, fr = lane & 15, fq = lane >> 4;
    const int K = g.K, nt = K / BK;
    unsigned voffA[2], voffB[2];
#pragma unroll
    for (int i = 0; i < 2; ++i) { int R, C; stage_rc(tid * 16 + i * 8192, R, C); const int Rb = Epi::PERM ? ((R & ~31) + perm32(R & 31)) : R;
        voffA[i] = TA ? (unsigned)(R * BK + C) * 2u : (unsigned)(R * K + C) * 2u; voffB[i] = TB ? (unsigned)(Rb * BK + C) * 2u : (unsigned)(Rb * K + C) * 2u; }
    const size_t kstepA = TA ? (size_t)(BM * BK * 2) : (size_t)(BK * 2), kstepB = TB ? (size_t)(BM * BK * 2) : (size_t)(BK * 2);
    const size_t hstepA = TA ? (size_t)(HALF * BK * 2) : (size_t)HALF * K * 2, hstepB = TB ? (size_t)(HALF * BK * 2) : (size_t)HALF * K * 2;
    const size_t tstepA = (size_t)BM * K * 2, tstepB = (size_t)BM * K * 2;
    const unsigned ldsw = (unsigned)wid * 1024u;
    const int aoff = lds_byte(wr * 64 + fr, fq * 8), boff = lds_byte(wc * 32 + fr, fq * 8);
#define PG8_SA(b, h) (((b) * 2 + (h)) * HTB)
#define PG8_SB(b, h) ((4 + (b) * 2 + (h)) * HTB)
#define PG8_STAGE(bufoff, gbase, voff) do { _Pragma("unroll") for (int _i = 0; _i < 2; ++_i) \
        __builtin_amdgcn_global_load_lds((const unsigned*)((const char*)(gbase) + (voff)[_i]), (PG8_LAS unsigned*)(lds + (bufoff) + ldsw + _i * 8192), 16, 0, 0); } while (0)
#define PG8_LDA(dst, b, h) do { _Pragma("unroll") for (int m = 0; m < 4; ++m) _Pragma("unroll") for (int k = 0; k < 2; ++k) dst[m][k] = *(const PG8_LAS bf16x8*)(lds + PG8_SA(b, h) + aoff + m * 2048 + k * 1024); } while (0)
#define PG8_LDB(dst, b, h) do { _Pragma("unroll") for (int n = 0; n < 2; ++n) _Pragma("unroll") for (int k = 0; k < 2; ++k) dst[n][k] = *(const PG8_LAS bf16x8*)(lds + PG8_SB(b, h) + boff + n * 2048 + k * 1024); } while (0)
#define PG8_MMA(ai, bj, At, Bt) do { __builtin_amdgcn_s_setprio(1); _Pragma("unroll") for (int m = 0; m < 4; ++m) _Pragma("unroll") for (int n = 0; n < 2; ++n) _Pragma("unroll") for (int k = 0; k < 2; ++k) \
        acc[ai][bj][m][n] = __builtin_amdgcn_mfma_f32_16x16x32_bf16(Bt[n][k], At[m][k], acc[ai][bj][m][n], 0, 0, 0); __builtin_amdgcn_s_setprio(0); } while (0)
#define PG8_WAIT_V(n) asm volatile("s_waitcnt vmcnt(" #n ")" ::: "memory")
#define PG8_WAIT_L(n) asm volatile("s_waitcnt lgkmcnt(" #n ")" ::: "memory")
#define PG8_BAR __builtin_amdgcn_s_barrier()
#define PG8_SCHED __builtin_amdgcn_sched_barrier(0)
    Unit cur, nxt; int ui = 0;
    if (!S.next(0, cur)) return;
    f32x4 acc[2][2][4][2];
#pragma unroll
    for (int a = 0; a < 2; ++a)
#pragma unroll
        for (int b = 0; b < 2; ++b)
#pragma unroll
            for (int m = 0; m < 4; ++m)
#pragma unroll
                for (int n = 0; n < 2; ++n) acc[a][b][m][n] = (f32x4){0.f, 0.f, 0.f, 0.f};
    bf16x8 At[4][2], B0[2][2], B1[2][2];
    const char* cA = (const char*)g.A + (size_t)cur.pm * tstepA; const char* cB = (const char*)g.Bt + (size_t)cur.pn * tstepB;
    S.a_ready(cur);
    if constexpr (SP2) {
        PG8_STAGE(PG8_SB(0, 0), cB, voffB); PG8_STAGE(PG8_SB(0, 1), cB + hstepB, voffB); PG8_STAGE(PG8_SA(0, 0), cA, voffA); PG8_STAGE(PG8_SA(0, 1), cA + hstepA, voffA);
        if (wr == 1) PG8_BAR;
        PG8_WAIT_V(2); PG8_BAR;
        PG8_STAGE(PG8_SB(1, 0), cB + kstepB, voffB); PG8_STAGE(PG8_SA(1, 0), cA + kstepA, voffA); PG8_STAGE(PG8_SB(1, 1), cB + hstepB + kstepB, voffB);
        PG8_WAIT_V(6); PG8_BAR;
    } else {
        PG8_STAGE(PG8_SB(0, 0), cB, voffB); PG8_STAGE(PG8_SA(0, 0), cA, voffA); PG8_STAGE(PG8_SB(0, 1), cB + hstepB, voffB); PG8_STAGE(PG8_SA(0, 1), cA + hstepA, voffA);
        if (wr == 1) PG8_BAR;
        PG8_WAIT_V(4); PG8_BAR;
        PG8_STAGE(PG8_SB(1, 0), cB + kstepB, voffB); PG8_STAGE(PG8_SA(1, 0), cA + kstepA, voffA); PG8_STAGE(PG8_SB(1, 1), cB + hstepB + kstepB, voffB);
        PG8_WAIT_V(6); PG8_BAR;
    }
    for (;;) {
        const bool has_next = S.next(ui + 1, nxt);
        const char* nA = has_next ? (const char*)g.A + (size_t)nxt.pm * tstepA : cA; const char* nB = has_next ? (const char*)g.Bt + (size_t)nxt.pn * tstepB : cB;
        for (int t = 0; t < nt; t += 2) {
            const bool last = (t == nt - 2);
            const char* a1 = cA + (size_t)(t + 1) * kstepA;
            const char* a2 = last ? nA : cA + (size_t)(t + 2) * kstepA; const char* b2 = last ? nB : cB + (size_t)(t + 2) * kstepB;
            const char* a3 = a2 + kstepA; const char* b3 = b2 + kstepB;
            if (last && has_next) S.a_ready(nxt);
            if constexpr (SP2) {
            PG8_LDB(B0, 0, 0); PG8_LDB(B1, 0, 1); PG8_SCHED; PG8_LDA(At, 0, 0); PG8_STAGE(PG8_SA(1, 1), a1 + hstepA, voffA);
            PG8_WAIT_V(8); PG8_WAIT_L(0); PG8_BAR; PG8_MMA(0, 0, At, B0); PG8_MMA(0, 1, At, B1); PG8_BAR; PG8_SCHED;
            PG8_LDA(At, 0, 1); PG8_STAGE(PG8_SB(0, 0), b2, voffB); PG8_STAGE(PG8_SB(0, 1), b2 + hstepB, voffB); PG8_STAGE(PG8_SA(0, 0), a2, voffA);
            PG8_WAIT_V(8); PG8_WAIT_L(0); PG8_BAR; PG8_MMA(1, 0, At, B0); PG8_MMA(1, 1, At, B1); PG8_BAR; PG8_SCHED;
            PG8_LDB(B0, 1, 0); PG8_LDB(B1, 1, 1); PG8_SCHED; PG8_LDA(At, 1, 0); PG8_STAGE(PG8_SA(0, 1), a2 + hstepA, voffA);
            PG8_WAIT_V(8); PG8_WAIT_L(0); PG8_BAR; PG8_MMA(0, 0, At, B0); PG8_MMA(0, 1, At, B1); PG8_BAR; PG8_SCHED;
            PG8_LDA(At, 1, 1); PG8_STAGE(PG8_SB(1, 0), b3, voffB); PG8_STAGE(PG8_SB(1, 1), b3 + hstepB, voffB); PG8_STAGE(PG8_SA(1, 0), a3, voffA);
            PG8_WAIT_V(8); PG8_WAIT_L(0); PG8_BAR; PG8_MMA(1, 0, At, B0); PG8_MMA(1, 1, At, B1); PG8_BAR; PG8_SCHED;
            } else {
            PG8_LDB(B0, 0, 0); PG8_SCHED; PG8_LDA(At, 0, 0); PG8_STAGE(PG8_SA(1, 1), a1 + hstepA, voffA);
            PG8_WAIT_L(8); PG8_BAR; PG8_WAIT_L(0); PG8_MMA(0, 0, At, B0); PG8_BAR; PG8_SCHED;
            PG8_LDB(B1, 0, 1); PG8_STAGE(PG8_SB(0, 0), b2, voffB);
            PG8_BAR; PG8_WAIT_L(0); PG8_MMA(0, 1, At, B1); PG8_BAR;
            PG8_LDA(At, 0, 1); PG8_STAGE(PG8_SA(0, 0), a2, voffA);
            PG8_BAR; PG8_WAIT_L(0); PG8_MMA(1, 0, At, B0); PG8_BAR; PG8_SCHED;
            PG8_STAGE(PG8_SB(0, 1), b2 + hstepB, voffB);
            PG8_WAIT_V(6); PG8_BAR; PG8_MMA(1, 1, At, B1); PG8_BAR;
            PG8_LDB(B0, 1, 0); PG8_SCHED; PG8_LDA(At, 1, 0); PG8_STAGE(PG8_SA(0, 1), a2 + hstepA, voffA);
            PG8_WAIT_L(8); PG8_BAR; PG8_WAIT_L(0); PG8_MMA(0, 0, At, B0); PG8_BAR; PG8_SCHED;
            PG8_LDB(B1, 1, 1); PG8_STAGE(PG8_SB(1, 0), b3, voffB);
            PG8_BAR; PG8_WAIT_L(0); PG8_MMA(0, 1, At, B1); PG8_BAR;
            PG8_LDA(At, 1, 1); PG8_STAGE(PG8_SA(1, 0), a3, voffA);
            PG8_BAR; PG8_WAIT_L(0); PG8_MMA(1, 0, At, B0); PG8_BAR; PG8_SCHED;
            PG8_STAGE(PG8_SB(1, 1), b3 + hstepB, voffB);
            PG8_WAIT_V(6); PG8_BAR; PG8_MMA(1, 1, At, B1); PG8_BAR;
            }
        }
        if constexpr (ALIGN_EPI) { if (wr == 0) PG8_BAR; }
        if constexpr (!Epi::AFTER_DRAIN) { E(acc, cur, wr, wc, fr, fq); S.done(cur); }
        if (!has_next) break;
#pragma unroll
        for (int a = 0; a < 2; ++a)
#pragma unroll
            for (int b = 0; b < 2; ++b)
#pragma unroll
                for (int m = 0; m < 4; ++m)
#pragma unroll
                    for (int n = 0; n < 2; ++n) acc[a][b][m][n] = (f32x4){0.f, 0.f, 0.f, 0.f};
        cur = nxt; cA = nA; cB = nB; ++ui;
        if constexpr (ALIGN_EPI) { if (wr == 1) PG8_BAR; }
    }
    PG8_WAIT_V(0);
    if constexpr (!ALIGN_EPI) { if (wr == 0) PG8_BAR; }
    PG8_BAR;
    if constexpr (Epi::AFTER_DRAIN) { E.fused(acc, cur, wr, wc, fr, fq, lds, wid, lane); S.done(cur); }
#undef PG8_SA
#undef PG8_SB
#undef PG8_STAGE
#undef PG8_LDA
#undef PG8_LDB
#undef PG8_MMA
#undef PG8_WAIT_V
#undef PG8_WAIT_L
#undef PG8_BAR
#undef PG8_SCHED
}
}

constexpr int NWAVES = 8;
#ifndef MK_N_LAUNCHES
#define MK_N_LAUNCHES 1
#endif
constexpr int N_LAUNCHES = MK_N_LAUNCHES;
constexpr int NPHASE = 12;

constexpr int DM = 4096, DFF = 11008, NTOK = 8192, NCTX = 4096, LAT_T = 2048, CTX_T = 256, INW = 9216, MODW = 36864;
constexpr int ZK = 2048, ZV = 2560, ZB = 3072, ZC = 5120, ZH = 7168;
constexpr float EPS = 1e-6f;

constexpr size_t MiB = 1u << 20;
constexpr size_t WS_CTL = 0, CTL_ZERO_BYTES = 1 * MiB;
constexpr size_t WS_MOD = 1 * MiB, WS_ROPE = 2 * MiB, WS_CK = 3 * MiB, WS_CV = 3 * MiB + 512 * 1024;
constexpr size_t WS_WGU1 = 4 * MiB, WS_WD1 = 176 * MiB, WS_WIN = 262 * MiB, WS_WO = 334 * MiB, WS_WGU2 = 366 * MiB, WS_WD2 = 538 * MiB;
constexpr size_t WS_U = 624 * MiB, WS_MRG = 688 * MiB, WS_ACT = 752 * MiB, WS_O = 924 * MiB, WS_H = 1052 * MiB, WS_Z = 1180 * MiB, WS_END = 1324 * MiB;
constexpr int CW_BAR = 4096;

constexpr int RING_BYTES = 131072;
constexpr int ATT_STG = 32 * 2064;
constexpr int ATT_WS_OFF = 2 * ATT_STG;
constexpr int LDSCTL_OFF = ATT_WS_OFF + 2048;
constexpr int MISC_OFF = LDSCTL_OFF + 64;
constexpr int LDS_BYTES = 135168;
static_assert(MISC_OFF + 64 <= LDS_BYTES, "LDS map");

#define GAS __attribute__((address_space(1)))
#define LAS __attribute__((address_space(3)))
typedef unsigned short bf16;
typedef unsigned v4u __attribute__((ext_vector_type(4)));
typedef unsigned v2u __attribute__((ext_vector_type(2)));
typedef float f32x4 __attribute__((ext_vector_type(4)));
typedef float f32x2 __attribute__((ext_vector_type(2)));
typedef short bf16x8 __attribute__((ext_vector_type(8)));
typedef short s16x4 __attribute__((ext_vector_type(4)));
typedef float f32x16 __attribute__((ext_vector_type(16)));
typedef GAS unsigned gu32;
#define RLX_AGENT __ATOMIC_RELAXED, __HIP_MEMORY_SCOPE_AGENT
#define LDS_WAIT() asm volatile("s_waitcnt lgkmcnt(0)" ::: "memory")
#define VM_WAIT() asm volatile("s_waitcnt vmcnt(0)" ::: "memory")
__device__ __forceinline__ unsigned f2bf(float f) { unsigned u = __builtin_bit_cast(unsigned, f); return (u + 0x7fffu + ((u >> 16) & 1u)) >> 16; }
__device__ __forceinline__ unsigned pk2(float lo, float hi) { return f2bf(lo) | (f2bf(hi) << 16); }
__device__ __forceinline__ float bflo(unsigned w) { return __builtin_bit_cast(float, w << 16); }
__device__ __forceinline__ float bfhi(unsigned w) { return __builtin_bit_cast(float, w & 0xffff0000u); }
template <int CTRL> __device__ __forceinline__ float dpp_f(float v) { return __builtin_bit_cast(float, __builtin_amdgcn_update_dpp(0, __builtin_bit_cast(int, v), CTRL, 0xf, 0xf, true)); }
__device__ __forceinline__ float wave_sum(float v) {
    v += dpp_f<0xB1>(v); v += dpp_f<0x4E>(v); v += dpp_f<0x141>(v); v += dpp_f<0x140>(v);
    const int b = __builtin_bit_cast(int, v);
    return (__builtin_bit_cast(float, __builtin_amdgcn_readlane(b, 0)) + __builtin_bit_cast(float, __builtin_amdgcn_readlane(b, 16))) +
           (__builtin_bit_cast(float, __builtin_amdgcn_readlane(b, 32)) + __builtin_bit_cast(float, __builtin_amdgcn_readlane(b, 48)));
}
__device__ __forceinline__ int opaque(int v) { asm volatile("" : "+v"(v)); return v; }
__device__ __forceinline__ size_t tiled_idx(int row, int col, int KT) { return ((size_t)(row >> 8) * KT + (col >> 6)) * 16384 + (size_t)((row & 255) * 64 + (col & 63)); }
#define XB_TMO      128
#define XB_XCNT(j)  (256  + 64 * (j))
#define XB_XSUB(j)  (1280 + 64 * (j))
#define XB_XGEN(j)  (2304 + 64 * (j))
#define XB_TOP      3328
#define XB_TOPGEN   3392
#define XCD_BAR_WORDS 3456
#define XB_SPIN_CAP (1u << 18)

__device__ __forceinline__ unsigned xb_ld(unsigned* p)              { return __hip_atomic_load(p, __ATOMIC_RELAXED, __HIP_MEMORY_SCOPE_AGENT); }
__device__ __forceinline__ unsigned xb_add(unsigned* p, unsigned v) { return __hip_atomic_fetch_add(p, v, __ATOMIC_RELAXED, __HIP_MEMORY_SCOPE_AGENT); }
__device__ __forceinline__ unsigned xb_xcc_id() { return (unsigned)__builtin_amdgcn_s_getreg((3 << 11) | 20) & 0xFu; }
#define XB_SPIN(cond, bar) do { unsigned _sp = 0; while (cond) { __builtin_amdgcn_s_sleep(1); \
    if ((++_sp & 255u) == 0u) { if (xb_ld(&(bar)[XB_TMO])) break; if (_sp > XB_SPIN_CAP) { atomicAdd(&(bar)[XB_TMO], 1u); break; } } } } while (0)

struct XcdBarrier {
    unsigned* bar; unsigned x;
    volatile LAS unsigned* st;
};

__device__ __forceinline__ XcdBarrier xcd_barrier_post(unsigned* bar, volatile LAS unsigned* st) {
    XcdBarrier b; b.bar = bar; b.x = xb_xcc_id(); b.st = st;
    if (threadIdx.x == 0) (void)xb_add(&bar[XB_XCNT(b.x)], 1u);
    return b;
}
__device__ __forceinline__ void xcd_barrier_complete(unsigned* bar, unsigned x, unsigned& nloc, unsigned& nx) {
    const unsigned G = gridDim.x * gridDim.y * gridDim.z;
    unsigned sum, cnt, mine, sp = 0u;
    for (;;) {
        sum = 0u; cnt = 0u; mine = 0u;
#pragma unroll
        for (unsigned j = 0; j < 16; ++j) { const unsigned c = xb_ld(&bar[XB_XCNT(j)]); sum += c; cnt += (c > 0u) ? 1u : 0u; mine = (j == x) ? c : mine; }
        if (sum == G) break;
        __builtin_amdgcn_s_sleep(1);
        if ((++sp & 255u) == 0u) { if (xb_ld(&bar[XB_TMO])) break; if (sp > XB_SPIN_CAP) { atomicAdd(&bar[XB_TMO], 1u); break; } }
    }
    nloc = mine > 0u ? mine : 1u; nx = cnt > 0u ? cnt : 1u;
}

__device__ __forceinline__ void xcd_barrier(const XcdBarrier& b) {
    asm volatile("s_waitcnt vmcnt(0)" ::: "memory");
    __syncthreads();
    if (threadIdx.x == 0) {
        unsigned* bar = b.bar;
        __builtin_amdgcn_s_waitcnt(0);
        unsigned nloc = b.st[0], nx = b.st[1];
        if (nloc == 0u) { xcd_barrier_complete(bar, b.x, nloc, nx); b.st[0] = nloc; b.st[1] = nx; }
        const unsigned old = xb_add(&bar[XB_XSUB(b.x)], 1u);
        const unsigned gen = old / nloc;
        if (old + 1u == (gen + 1u) * nloc) {
            __builtin_amdgcn_fence(__ATOMIC_RELEASE, "agent");
            asm volatile("s_waitcnt vmcnt(0)" ::: "memory");
            const unsigned og = xb_add(&bar[XB_TOP], 1u);
            const unsigned tg = og / nx;
            if (og + 1u == (tg + 1u) * nx) xb_add(&bar[XB_TOPGEN], 1u);
            else XB_SPIN(xb_ld(&bar[XB_TOPGEN]) == tg, bar);
            __builtin_amdgcn_fence(__ATOMIC_ACQUIRE, "agent");
            xb_add(&bar[XB_XGEN(b.x)], 1u);
            asm volatile("s_waitcnt vmcnt(0)" ::: "memory");
        } else {
            XB_SPIN(xb_ld(&bar[XB_XGEN(b.x)]) == gen, bar);
            __builtin_amdgcn_fence(__ATOMIC_ACQUIRE, "agent");
            asm volatile("s_waitcnt vmcnt(0)" ::: "memory");
        }
    }
    __syncthreads();
}

struct TItem { const float* src; const float* kscale; bf16* dst; int N; int nt; };
__device__ __forceinline__ unsigned cvtpk_rne(float lo, float hi) { unsigned r; asm volatile("v_cvt_pk_bf16_f32 %0, %1, %2" : "=v"(r) : "v"(lo), "v"(hi)); return r; }
__device__ __forceinline__ void titem_load(const TItem& t, int lane, f32x4 (&v)[8]) {
    const float* p = t.src + (size_t)(8 * (lane >> 3)) * t.N + 4 * (lane & 7);
#pragma unroll
    for (int j = 0; j < 8; ++j) v[j] = __builtin_nontemporal_load((const f32x4*)(p + (size_t)j * t.N));
}
__device__ __forceinline__ void titem_store(const TItem& t, int lane, f32x4 (&v)[8]) {
    const int kg = lane >> 3, n4 = lane & 7;
    if (t.kscale) { const f32x4 s0 = *(const f32x4*)(t.kscale + 8 * kg), s1 = *(const f32x4*)(t.kscale + 8 * kg + 4);
        v[0] *= s0[0]; v[1] *= s0[1]; v[2] *= s0[2]; v[3] *= s0[3]; v[4] *= s1[0]; v[5] *= s1[1]; v[6] *= s1[2]; v[7] *= s1[3]; }
    bf16* d = t.dst + (4 * n4) * 64 + 8 * kg;
#pragma unroll
    for (int i = 0; i < 4; ++i) { v4u o; o.x = cvtpk_rne(v[0][i], v[1][i]); o.y = cvtpk_rne(v[2][i], v[3][i]); o.z = cvtpk_rne(v[4][i], v[5][i]); o.w = cvtpk_rne(v[6][i], v[7][i]);
        if (t.nt) __builtin_nontemporal_store(o, (v4u*)(d + i * 64)); else *(GAS v4u*)(d + i * 64) = o; }
}
__device__ __forceinline__ TItem titem_make(const float* W, int K, int N, bf16* WT, int dst_row0, int k0, int n0, const float* kscale, int nt = 0) {
    TItem t; t.src = W + (size_t)k0 * N + n0; t.kscale = kscale; t.N = N; t.nt = nt;
    t.dst = WT + ((size_t)(dst_row0 >> 8) * (K >> 6) + (k0 >> 6)) * (256 * 64) + (dst_row0 & 255) * 64; return t;
}
__device__ __forceinline__ int gu_row(int n0, int up) { return 256 * (n0 >> 7) + (n0 & 127) + (up ? 128 : 0); }
__device__ __forceinline__ int in_row(int n0) {
    if (n0 >= ZV) return n0;
    const int rb = n0 < ZK ? 0 : ZK, c = n0 - rb, head = c >> 7, d0 = c & 127, axis = d0 >> 6, x2 = (d0 >> 5) & 1;
    return rb + (head >> 1) * 256 + x2 * 128 + (head & 1) * 64 + axis * 32;
}

struct P0Args { const float *c, *cache_k, *cache_v, *c_ctx, *w_mod, *b_mod, *w_in, *g_attn, *g_conv, *w_o, *wg1, *wu1, *wd1, *wg2, *wu2, *wd2;
                float *MOD, *ROPE; bf16 *CK, *CV, *WGU1, *WD1, *WIN, *WO, *WGU2, *WD2; };
constexpr int I_GU = (DM / 64) * (DFF / 32), I_D = (DFF / 64) * (DM / 32), I_IN = (DM / 64) * (INW / 32), I_O = (DM / 64) * (DM / 32);
constexpr int CI_P0_END = 2 * I_GU + I_IN + I_O, CI_WD1_END = CI_P0_END + I_D, CI_GU2_END = CI_WD1_END + 2 * I_GU, CI_END = CI_GU2_END + I_D;
constexpr int CI_X1 = CI_WD1_END + 30208, CI_X2 = CI_GU2_END + 4928;
static_assert(CI_X1 < CI_GU2_END && CI_X2 < CI_END, "split points");
__device__ __forceinline__ TItem titem_decode(const P0Args& A, int it) {
    int r = it;
    if (r < I_GU) { const int kb = r / (DFF / 32), nb = r % (DFF / 32); return titem_make(A.wg1, DM, DFF, A.WGU1, gu_row(32 * nb, 0), 64 * kb, 32 * nb, nullptr); } r -= I_GU;
    if (r < I_GU) { const int kb = r / (DFF / 32), nb = r % (DFF / 32); return titem_make(A.wu1, DM, DFF, A.WGU1, gu_row(32 * nb, 1), 64 * kb, 32 * nb, nullptr); } r -= I_GU;
    if (r < I_IN) { const int kb = r / (INW / 32), nb = r % (INW / 32); return titem_make(A.w_in, DM, INW, A.WIN, in_row(32 * nb), 64 * kb, 32 * nb, nullptr, 1); } r -= I_IN;
    if (r < I_O) { const int kb = r / (DM / 32), nb = r % (DM / 32); const int k0 = 64 * kb; return titem_make(A.w_o, DM, DM, A.WO, 32 * nb, k0, 32 * nb, k0 < 2048 ? A.g_attn + k0 : A.g_conv + (k0 - 2048), 1); } r -= I_O;
    if (r < I_D) { const int kb = r / (DM / 32), nb = r % (DM / 32); return titem_make(A.wd1, DFF, DM, A.WD1, 32 * nb, 64 * kb, 32 * nb, nullptr); } r -= I_D;
    if (r < I_GU) { const int kb = r / (DFF / 32), nb = r % (DFF / 32); return titem_make(A.wg2, DM, DFF, A.WGU2, gu_row(32 * nb, 0), 64 * kb, 32 * nb, nullptr, 1); } r -= I_GU;
    if (r < I_GU) { const int kb = r / (DFF / 32), nb = r % (DFF / 32); return titem_make(A.wu2, DM, DFF, A.WGU2, gu_row(32 * nb, 1), 64 * kb, 32 * nb, nullptr, 1); } r -= I_GU;
    { const int kb = r / (DM / 32), nb = r % (DM / 32); return titem_make(A.wd2, DFF, DM, A.WD2, 32 * nb, 64 * kb, 32 * nb, nullptr); }
}
__device__ __forceinline__ void convert_items(LAS unsigned char* lds, const P0Args& A, int wave, int lane, int it_begin, int it_end, int worker, int n_workers) {
    int it = it_begin + worker; if (it >= it_end) return;
    TItem ta = titem_decode(A, it), tb = ta; f32x4 va[8], vb[8]; titem_load(ta, lane, va);
    for (;;) {
        int nit = it + n_workers; bool more = nit < it_end;
        if (more) { tb = titem_decode(A, nit); titem_load(tb, lane, vb); }
        titem_store(ta, lane, va);
        if (!more) break;
        it = nit; nit = it + n_workers; more = nit < it_end;
        if (more) { ta = titem_decode(A, nit); titem_load(ta, lane, va); }
        titem_store(tb, lane, vb);
        if (!more) break;
        it = nit; }
}
__device__ __forceinline__ void tail_convert(LAS unsigned char* lds, const P0Args& A, int wave, int lane, int G, int nunits, int it_begin, int it_end) {
    const int first = nunits % G;
    if ((int)blockIdx.x >= first) convert_items(lds, A, wave, lane, it_begin, it_end, ((int)blockIdx.x - first) * NWAVES + wave, (G - first) * NWAVES);
}
__device__ __forceinline__ void phase0(LAS unsigned char* lds, const P0Args& A, int tid, int wave, int lane, int G) {
    LAS float* SC = (LAS float*)(lds + 67584);
    LAS float* RED = (LAS float*)(lds + 116736);
    for (int i = tid; i < 3 * DM; i += NWAVES * 64) { const int c = i >> 12, k = i & 4095; const float x = c == 0 ? A.c_ctx[k] : A.c[(c - 1) * DM + k]; SC[i] = x / (1.0f + __expf(-x)); }
    __syncthreads();
    for (int ch = blockIdx.x; ch < 256; ch += G) {
        f32x4 a0 = {0.f, 0.f, 0.f, 0.f}, a1 = a0, a2 = a0;
        if (lane < 36) { const float* wp = A.w_mod + (size_t)(512 * wave) * MODW + 144 * ch + 4 * lane; const LAS float* sc = SC + 512 * wave;
            for (int k = 0; k < 512; k += 16) { f32x4 w[16];
#pragma unroll
                for (int u = 0; u < 16; ++u) w[u] = __builtin_nontemporal_load((const f32x4*)(wp + (size_t)(k + u) * MODW));
#pragma unroll
                for (int u = 0; u < 16; ++u) { a0 += sc[k + u] * w[u]; a1 += sc[DM + k + u] * w[u]; a2 += sc[2 * DM + k + u] * w[u]; } }
            *(LAS f32x4*)(RED + (wave * 3 + 0) * 144 + 4 * lane) = a0; *(LAS f32x4*)(RED + (wave * 3 + 1) * 144 + 4 * lane) = a1; *(LAS f32x4*)(RED + (wave * 3 + 2) * 144 + 4 * lane) = a2; }
        __syncthreads();
        if (tid < 432) { const int c = tid / 144, j = tid % 144; float s = 0.f;
#pragma unroll
            for (int w = 0; w < 8; ++w) s += RED[(w * 3 + c) * 144 + j];
            A.MOD[(size_t)c * MODW + 144 * ch + j] = s + A.b_mod[144 * ch + j]; }
        __syncthreads();
    }
    const int gtid = blockIdx.x * (NWAVES * 64) + tid, gthreads = G * NWAVES * 64;
    for (int i = gtid; i < 2048; i += gthreads) { const int pos = i >> 5, fi = i & 31; const float f = powf(10000.0f, -(float)fi / 32.0f); const float a = (float)pos * f; A.ROPE[2 * i] = cosf(a); A.ROPE[2 * i + 1] = sinf(a); }
    for (int i = gtid; i < 65536; i += gthreads) { const int which = i >> 15, j = i & 32767; const float* src = (which ? A.cache_v : A.cache_k) + (size_t)j * 8;
        const f32x4 x0 = *(const f32x4*)src, x1 = *(const f32x4*)(src + 4); v4u o; o.x = pk2(x0[0], x0[1]); o.y = pk2(x0[2], x0[3]); o.z = pk2(x1[0], x1[1]); o.w = pk2(x1[2], x1[3]);
        *(v4u*)((which ? A.CV : A.CK) + (size_t)j * 8) = o; }
    convert_items(lds, A, wave, lane, 0, CI_P0_END, blockIdx.x * NWAVES + wave, G * NWAVES);
}

struct RowF { f32x4 a[8], b[8]; };
__device__ __forceinline__ void row_load_f32(RowF& r, const float* p, int lane) {
    const f32x4* q = (const f32x4*)p + 2 * lane;
#pragma unroll
    for (int j = 0; j < 8; ++j) { r.a[j] = __builtin_nontemporal_load(q + 128 * j); r.b[j] = __builtin_nontemporal_load(q + 128 * j + 1); }
}
__device__ __forceinline__ float ssq4(const f32x4 v) { return (v[0] * v[0] + v[1] * v[1]) + (v[2] * v[2] + v[3] * v[3]); }
constexpr int RV_PV = 0, RV_PA = 16384, RV_PS = 32768;
__device__ __forceinline__ f32x4 rv_ld(const LAS unsigned char* v, int j, int h, int lane) { return *(const LAS f32x4*)(v + ((2 * j + h) * 64 + lane) * 16); }
__device__ __forceinline__ void rv_st(LAS unsigned char* v, int tid, f32x4 x0, f32x4 x1) {
    const int j = tid >> 6, l = tid & 63; *(LAS f32x4*)(v + ((2 * j) * 64 + l) * 16) = x0; *(LAS f32x4*)(v + ((2 * j + 1) * 64 + l) * 16) = x1;
}
__device__ __forceinline__ void rows_fill_post(LAS unsigned char* lds, const float* gate, const float* gpost, int tid) {
    const f32x4 ga0 = ((const f32x4*)gate)[2 * tid], ga1 = ((const f32x4*)gate)[2 * tid + 1], gp0 = ((const f32x4*)gpost)[2 * tid], gp1 = ((const f32x4*)gpost)[2 * tid + 1];
    rv_st(lds + RV_PV, tid, ga0 * gp0, ga1 * gp1);
}
__device__ __forceinline__ void rows_fill_pre(LAS unsigned char* lds, const float* gpre, const float* shift, const float* scale, int tid) {
    const f32x4 g0 = ((const f32x4*)gpre)[2 * tid], g1 = ((const f32x4*)gpre)[2 * tid + 1], c0 = ((const f32x4*)scale)[2 * tid], c1 = ((const f32x4*)scale)[2 * tid + 1];
    rv_st(lds + RV_PA, tid, g0 * (1.0f + c0), g1 * (1.0f + c1));
    rv_st(lds + RV_PS, tid, ((const f32x4*)shift)[2 * tid], ((const f32x4*)shift)[2 * tid + 1]);
}
__device__ __forceinline__ void row_emit_u(const RowF& h, float r, const LAS unsigned char* lds, bf16* U, int row, int lane) {
#pragma unroll
    for (int jj = 0; jj < 8; jj += 2) {
#pragma unroll
        for (int j = jj; j < jj + 2; ++j) {
            const f32x4 a0 = rv_ld(lds + RV_PA, j, 0, lane), a1 = rv_ld(lds + RV_PA, j, 1, lane), s0 = rv_ld(lds + RV_PS, j, 0, lane), s1 = rv_ld(lds + RV_PS, j, 1, lane);
            const f32x4 y0 = (h.a[j] * r) * a0 + s0, y1 = (h.b[j] * r) * a1 + s1;
            v4u w; w.x = cvtpk_rne(y0[0], y0[1]); w.y = cvtpk_rne(y0[2], y0[3]); w.z = cvtpk_rne(y1[0], y1[1]); w.w = cvtpk_rne(y1[2], y1[3]); *(v4u*)(U + tiled_idx(row, 8 * lane + 512 * j, DM / 64)) = w; }
        asm volatile("" ::: "memory"); }
}
#define ROW_SRC(row) ((row) < NCTX ? x_prompt + (size_t)(row) * DM : x_sample + (size_t)((row) - NCTX) * DM)
#define RB_MOD(rb, s, j) (MOD + (size_t)((rb) < NCTX / 32 ? 0 : 1 + (((rb) - NCTX / 32) >> 6)) * MODW + ((s) * 3 + (j)) * DM)
__device__ __forceinline__ void rows_pre(LAS unsigned char* lds, const float* x_prompt, const float* x_sample, const float* MOD, const float* gpre, bf16* U, int tid, int wave, int lane0, int G) {
    for (int rb = blockIdx.x; rb < NTOK / 32; rb += G) { const int row0 = 32 * rb + wave;
        RowF nx; row_load_f32(nx, ROW_SRC(row0), lane0);
        rows_fill_pre(lds, gpre, RB_MOD(rb, 0, 0), RB_MOD(rb, 0, 1), tid);
        __syncthreads();
        for (int i = 0; i < 4; ++i) { const int row = row0 + 8 * i, lane = opaque(lane0);
            RowF h = nx; if (i < 3) row_load_f32(nx, ROW_SRC(row + 8), lane);
            float s = 0.f;
#pragma unroll
            for (int j = 0; j < 8; ++j) s += ssq4(h.a[j]) + ssq4(h.b[j]);
            const float r = 1.0f / sqrtf(wave_sum(s) * (1.0f / DM) + EPS);
            row_emit_u(h, r, lds, U, row, lane); }
        __syncthreads(); }
}
__device__ __forceinline__ void row_from_bf16(RowF& r, const v4u (&w)[8]) {
#pragma unroll
    for (int j = 0; j < 8; ++j) { r.a[j] = (f32x4){bflo(w[j].x), bfhi(w[j].x), bflo(w[j].y), bfhi(w[j].y)}; r.b[j] = (f32x4){bflo(w[j].z), bfhi(w[j].z), bflo(w[j].w), bfhi(w[j].w)}; }
}
template <bool NEXT, bool SRC_X, int S>
__device__ __forceinline__ void rows_post_pre(LAS unsigned char* lds, const float* x_prompt, const float* x_sample, bf16* Hb, const bf16* O, const float* MOD, float resw, const float* gpost, float* Yout,
                                              const float* gpre, bf16* U, int tid, int wave, int lane0, int G) {
    for (int rb = blockIdx.x; rb < NTOK / 32; rb += G) { const int row0 = 32 * rb + wave;
        RowF nh; v4u nhb[8], no[8];
        if constexpr (SRC_X) row_load_f32(nh, ROW_SRC(row0), lane0);
        else {
#pragma unroll
            for (int j = 0; j < 8; ++j) nhb[j] = __builtin_nontemporal_load(((const v4u*)(Hb + (size_t)row0 * DM)) + lane0 + 64 * j); }
#pragma unroll
        for (int j = 0; j < 8; ++j) no[j] = __builtin_nontemporal_load(((const v4u*)(O + (size_t)row0 * DM)) + lane0 + 64 * j);
        rows_fill_post(lds, RB_MOD(rb, S, 2), gpost, tid);
        if constexpr (NEXT) rows_fill_pre(lds, gpre, RB_MOD(rb, S + 1, 0), RB_MOD(rb, S + 1, 1), tid);
        __syncthreads();
        for (int i = 0; i < 4; ++i) { const int row = row0 + 8 * i, lane = opaque(lane0);
            RowF h; if constexpr (SRC_X) h = nh; else row_from_bf16(h, nhb);
            v4u o[8];
#pragma unroll
            for (int j = 0; j < 8; ++j) o[j] = no[j];
            const int nrow = row + 8;
            if (i < 3) {
#pragma unroll
                for (int j = 0; j < 8; ++j) no[j] = __builtin_nontemporal_load(((const v4u*)(O + (size_t)nrow * DM)) + lane + 64 * j);
                if constexpr (!SRC_X) {
#pragma unroll
                    for (int j = 0; j < 8; ++j) nhb[j] = __builtin_nontemporal_load(((const v4u*)(Hb + (size_t)nrow * DM)) + lane + 64 * j); } }
            float s = 0.f;
#pragma unroll
            for (int j = 0; j < 8; ++j) { const float a0 = bflo(o[j].x), a1 = bfhi(o[j].x), a2 = bflo(o[j].y), a3 = bfhi(o[j].y), a4 = bflo(o[j].z), a5 = bfhi(o[j].z), a6 = bflo(o[j].w), a7 = bfhi(o[j].w);
                s += ((a0 * a0 + a1 * a1) + (a2 * a2 + a3 * a3)) + ((a4 * a4 + a5 * a5) + (a6 * a6 + a7 * a7)); }
            const float ro = resw / sqrtf(wave_sum(s) * (1.0f / DM) + EPS);
            s = 0.f;
#pragma unroll
            for (int jj = 0; jj < 8; jj += 2) {
#pragma unroll
                for (int j = jj; j < jj + 2; ++j) {
                    const f32x4 pv0 = rv_ld(lds + RV_PV, j, 0, lane), pv1 = rv_ld(lds + RV_PV, j, 1, lane);
                    const f32x4 o0 = {bflo(o[j].x), bfhi(o[j].x), bflo(o[j].y), bfhi(o[j].y)}, o1 = {bflo(o[j].z), bfhi(o[j].z), bflo(o[j].w), bfhi(o[j].w)};
                    h.a[j] = h.a[j] + (ro * pv0) * o0; h.b[j] = h.b[j] + (ro * pv1) * o1; s += ssq4(h.a[j]) + ssq4(h.b[j]);
                    if constexpr (NEXT) { v4u w; w.x = cvtpk_rne(h.a[j][0], h.a[j][1]); w.y = cvtpk_rne(h.a[j][2], h.a[j][3]); w.z = cvtpk_rne(h.b[j][0], h.b[j][1]); w.w = cvtpk_rne(h.b[j][2], h.b[j][3]);
                        __builtin_nontemporal_store(w, ((v4u*)(Hb + (size_t)row * DM)) + lane + 64 * j); }
                    else { f32x4* yo = (f32x4*)(Yout + (size_t)row * DM) + 2 * lane; __builtin_nontemporal_store(h.a[j], yo + 128 * j); __builtin_nontemporal_store(h.b[j], yo + 128 * j + 1); } }
                asm volatile("" ::: "memory"); }
            if constexpr (SRC_X) { if (i < 3) row_load_f32(nh, ROW_SRC(nrow), lane); }
            if constexpr (NEXT) { const float r = 1.0f / sqrtf(wave_sum(s) * (1.0f / DM) + EPS);
                row_emit_u(h, r, lds, U, row, lane); } }
        __syncthreads(); }
}
#undef ROW_SRC
#undef RB_MOD

namespace att {
constexpr float SCALE = 0.088388347648318440f;
#define KSWZ(row, colB) ((row) * 256 + ((colB) ^ (((row) & 7) << 4)))
#define SBAR() __builtin_amdgcn_sched_barrier(0)
__device__ __forceinline__ int crow(int r, int hi) { return (r & 3) + 8 * (r >> 2) + 4 * hi; }
__device__ __forceinline__ unsigned cvtpk(float lo, float hi) { unsigned r; asm volatile("v_cvt_pk_bf16_f32 %0, %1, %2" : "=v"(r) : "v"(lo), "v"(hi)); return r; }
__device__ __forceinline__ void partialSM(f32x16& p0, f32x16& p1, float& m_reg, float& alpha) {
    constexpr float C = SCALE * 1.4426950408889634f;
    float pmax = p0[0];
#pragma unroll
    for (int r = 1; r < 16; ++r) pmax = fmaxf(pmax, p0[r]);
#pragma unroll
    for (int r = 0; r < 16; ++r) pmax = fmaxf(pmax, p1[r]);
    { auto rr = __builtin_amdgcn_permlane32_swap(__float_as_uint(pmax), __float_as_uint(pmax), false, false); pmax = fmaxf(__uint_as_float(rr[0]), __uint_as_float(rr[1])); }
    float mn;
    if (__all(pmax <= m_reg)) { mn = m_reg; alpha = 1.f; }
    else { mn = fmaxf(m_reg, pmax); alpha = __builtin_amdgcn_exp2f((m_reg - mn) * C); m_reg = mn; }
    const float mnC = -mn * C;
#pragma unroll
    for (int r = 0; r < 16; ++r) { p0[r] = __builtin_amdgcn_exp2f(fmaf(p0[r], C, mnC)); p1[r] = __builtin_amdgcn_exp2f(fmaf(p1[r], C, mnC)); }
}
__device__ __forceinline__ void finishSM(const f32x16& p0, const f32x16& p1, float alpha, float& l_reg, bf16x8& pa0, bf16x8& pa1, bf16x8& pa2, bf16x8& pa3) {
    float ps = 0;
#pragma unroll
    for (int r = 0; r < 16; ++r) ps += p0[r];
#pragma unroll
    for (int r = 0; r < 16; ++r) ps += p1[r];
    { auto rr = __builtin_amdgcn_permlane32_swap(__float_as_uint(ps), __float_as_uint(ps), false, false); ps = __uint_as_float(rr[0]) + __uint_as_float(rr[1]); }
    l_reg = l_reg * alpha + ps;
#define PK4(P, BASE, OUT) do { unsigned a0 = cvtpk(P[BASE + 0], P[BASE + 1]), a1 = cvtpk(P[BASE + 2], P[BASE + 3]);   \
    unsigned b0 = cvtpk(P[BASE + 4], P[BASE + 5]), b1 = cvtpk(P[BASE + 6], P[BASE + 7]);                              \
    auto r0 = __builtin_amdgcn_permlane32_swap(a0, b0, false, false); auto r1 = __builtin_amdgcn_permlane32_swap(a1, b1, false, false); \
    v4u w = {r0[0], r1[0], r0[1], r1[1]}; OUT = __builtin_bit_cast(bf16x8, w); } while (0)
    PK4(p0, 0, pa0); PK4(p0, 8, pa1); PK4(p1, 0, pa2); PK4(p1, 8, pa3);
#undef PK4
}
__device__ __forceinline__ void qkt(f32x16& p0, f32x16& p1, const LAS unsigned char* Ks, const bf16x8* qr, int r32, int hi) {
    p0 = f32x16{}; p1 = f32x16{};
#pragma unroll
    for (int d0 = 0; d0 < 8; ++d0) { const int cb = (d0 * 16 + hi * 8) * 2;
        const bf16x8 b0 = *(const LAS bf16x8*)(Ks + KSWZ(r32, cb));
        const bf16x8 b1 = *(const LAS bf16x8*)(Ks + KSWZ(32 + r32, cb));
        p0 = __builtin_amdgcn_mfma_f32_32x32x16_bf16(b0, qr[d0], p0, 0, 0, 0);
        p1 = __builtin_amdgcn_mfma_f32_32x32x16_bf16(b1, qr[d0], p1, 0, 0, 0); }
}
__device__ __forceinline__ int v_st(int k, int c) { const int kk = (k & ~0xC) | ((k & 4) << 1) | ((k & 8) >> 1); return ((kk >> 3) * 4 + (c >> 5)) * 512 + ((kk & 7) * 32 + (c & 31)) * 2; }
__device__ __forceinline__ int v_rd_base(int lane) { return ((lane & 3) << 3) | (((lane >> 2) & 3) << 6) | (((lane >> 4) & 1) << 5) | (((lane >> 5) & 1) << 8); }
constexpr int v_rd_off(int d0, int ks, int half) { return d0 * 512 + ks * 4096 + half * 2048; }
template <int OFF> __device__ __forceinline__ s16x4 tr_read(int vb) { s16x4 r; asm volatile("ds_read_b64_tr_b16 %0, %1 offset:%2" : "=&v"(r) : "v"(vb), "i"(OFF) : "memory"); return r; }
template <int D0> __device__ __forceinline__ void pv_one(f32x16& od, int vb, bf16x8 pa0, bf16x8 pa1, bf16x8 pa2, bf16x8 pa3) {
    const s16x4 l0 = tr_read<v_rd_off(D0, 0, 0)>(vb), h0 = tr_read<v_rd_off(D0, 0, 1)>(vb), l1 = tr_read<v_rd_off(D0, 1, 0)>(vb), h1 = tr_read<v_rd_off(D0, 1, 1)>(vb);
    const s16x4 l2 = tr_read<v_rd_off(D0, 2, 0)>(vb), h2 = tr_read<v_rd_off(D0, 2, 1)>(vb), l3 = tr_read<v_rd_off(D0, 3, 0)>(vb), h3 = tr_read<v_rd_off(D0, 3, 1)>(vb);
    asm volatile("s_waitcnt lgkmcnt(0)" ::: "memory"); SBAR();
#define PK(L, H) (bf16x8){L[0], L[1], L[2], L[3], H[0], H[1], H[2], H[3]}
    od = __builtin_amdgcn_mfma_f32_32x32x16_bf16(pa0, PK(l0, h0), od, 0, 0, 0);
    od = __builtin_amdgcn_mfma_f32_32x32x16_bf16(pa1, PK(l1, h1), od, 0, 0, 0);
    od = __builtin_amdgcn_mfma_f32_32x32x16_bf16(pa2, PK(l2, h2), od, 0, 0, 0);
    od = __builtin_amdgcn_mfma_f32_32x32x16_bf16(pa3, PK(l3, h3), od, 0, 0, 0);
#undef PK
}
__device__ __forceinline__ void pv_d0(f32x16* o, int vb, bf16x8 pa0, bf16x8 pa1, bf16x8 pa2, bf16x8 pa3) {
    pv_one<0>(o[0], vb, pa0, pa1, pa2, pa3); pv_one<1>(o[1], vb, pa0, pa1, pa2, pa3); pv_one<2>(o[2], vb, pa0, pa1, pa2, pa3); pv_one<3>(o[3], vb, pa0, pa1, pa2, pa3);
}
__device__ __forceinline__ void loadU8(const bf16* Z, int rowbase, int t, int L, int ch, float (&u)[8]) {
    const int tc = t < 0 ? 0 : (t >= L ? L - 1 : t); const float f = (t < 0 || t >= L) ? 0.f : 1.f;
    const bf16* zr = Z + (size_t)(rowbase + tc) * INW + ch; const v4u c8 = *(const v4u*)(zr + ZC), h8 = *(const v4u*)(zr + ZH);
    u[0] = bflo(c8.x) * bflo(h8.x) * f; u[1] = bfhi(c8.x) * bfhi(h8.x) * f; u[2] = bflo(c8.y) * bflo(h8.y) * f; u[3] = bfhi(c8.y) * bfhi(h8.y) * f;
    u[4] = bflo(c8.z) * bflo(h8.z) * f; u[5] = bfhi(c8.z) * bfhi(h8.z) * f; u[6] = bflo(c8.w) * bflo(h8.w) * f; u[7] = bfhi(c8.w) * bfhi(h8.w) * f;
}
__device__ __forceinline__ void attn_conv_unit(LAS unsigned char* lds, int unit, const bf16* Z, const bf16* CK, const bf16* CV, const float* sink, const float* wconv, bf16* MRG, int tid, int wid, int lane) {
    const bool lat = unit >= 128; const int v = lat ? unit - 128 : unit;
    const int seq = lat ? (v >> 6) : (v >> 3), blk = lat ? (v & 63) : (v & 7);
    const int rowbase = lat ? NCTX + seq * LAT_T : seq * CTX_T, t0 = blk * 32, L = lat ? LAT_T : CTX_T;
    const int r32 = lane & 31, hi = lane >> 5, set = wid >> 2;
    int lo = 0, n_win = 4;
    if (lat) { lo = (t0 - 128) >> 6; if (lo < 0) lo = 0; int up = (t0 + 159) >> 6; if (up > 31) up = 31; n_win = up - lo + 1; }
    const int n_tiles = lat ? n_win + 4 : 4;
    const LAS unsigned char* Kset = lds + set * 32768;
    LAS float* li_l = (LAS float*)(lds + ATT_WS_OFF) + wid * 64; LAS float* al_l = li_l + 32;
    const int vb0 = (int)(unsigned)(uintptr_t)(lds + set * 32768 + 16384) + v_rd_base(lane);
    const int sset = tid >> 8, t8 = tid & 255, sr = t8 >> 4, sc = (t8 & 15) * 8;
    LAS unsigned char* sK = lds + sset * 32768; LAS unsigned char* sV = sK + 16384;
    bf16x8 qr[8], kx[4], vx[4];
#define ATT_TILE_LOAD_H(TI, SKVH) do { const bf16 *Kp_, *Vp_; int pitch_; \
            if (!lat || (TI) < n_win) { const int k0_ = 64 * (lo + (TI)); Kp_ = Z + (size_t)(rowbase + k0_) * INW + ZK + (SKVH) * 128; Vp_ = Kp_ + (ZV - ZK); pitch_ = INW; } \
            else { const int j_ = (TI) - n_win; Kp_ = CK + (size_t)(seq * 256 + 64 * j_) * 512 + (SKVH) * 128; Vp_ = CV + (size_t)(seq * 256 + 64 * j_) * 512 + (SKVH) * 128; pitch_ = 512; } \
            _Pragma("unroll") for (int i_ = 0; i_ < 4; ++i_) { kx[i_] = *(const bf16x8*)(Kp_ + (size_t)(sr + 16 * i_) * pitch_ + sc); vx[i_] = *(const bf16x8*)(Vp_ + (size_t)(sr + 16 * i_) * pitch_ + sc); } } while (0)
#define ATT_TILE_LOAD(TI) ATT_TILE_LOAD_H(TI, skvh)
#define ATT_PASS_REQ(PASS) ATT_TILE_LOAD_H(0, 2 * (PASS) + sset)
    ATT_PASS_REQ(0);
    for (int pass = 0; pass < 2; ++pass) {
        const int kvh = 2 * pass + set, qhead = 4 * kvh + (wid & 3), skvh = 2 * pass + sset;
        { const bf16* qp = Z + (size_t)(rowbase + t0 + r32) * INW + qhead * 128 + hi * 8;
#pragma unroll
          for (int d0 = 0; d0 < 8; ++d0) qr[d0] = *(const bf16x8*)(qp + d0 * 16); }
        float m_reg = sink[qhead] * (1.0f / SCALE), l_reg = 1.0f; f32x16 o[4] = {};
        for (int ti = 0; ti < n_tiles; ++ti) {
            const bool masked = lat && ti < n_win; const int key0 = 64 * (lo + ti);
            __syncthreads();
#pragma unroll
            for (int i = 0; i < 4; ++i) { const int row = sr + 16 * i; *(LAS bf16x8*)(sK + KSWZ(row, sc * 2)) = kx[i]; *(LAS bf16x8*)(sV + v_st(row, sc)) = vx[i]; }
            __syncthreads();
            if (ti + 1 < n_tiles) ATT_TILE_LOAD(ti + 1);
            f32x16 p0, p1; qkt(p0, p1, Kset, qr, r32, hi);
            if (masked && (key0 < t0 - 97 || key0 > t0 + 65)) {
                const int db = opaque(t0 + r32 - key0 - 4 * hi + 128);
#pragma unroll
                for (int r = 0; r < 16; ++r) { const int c = (r & 3) + 8 * (r >> 2); if ((unsigned)(db - c) > 256u) p0[r] = -1e30f; if ((unsigned)(db - c - 32) > 256u) p1[r] = -1e30f; } }
            float alpha; partialSM(p0, p1, m_reg, alpha);
            if (__any(alpha < 1.f)) { if (hi == 0) al_l[r32] = alpha; LDS_WAIT();
#pragma unroll
                for (int d = 0; d < 4; ++d)
#pragma unroll
                    for (int r = 0; r < 16; ++r) o[d][r] *= al_l[crow(r, hi)]; }
            bf16x8 pa0, pa1, pa2, pa3; finishSM(p0, p1, alpha, l_reg, pa0, pa1, pa2, pa3);
            pv_d0(o, vb0, pa0, pa1, pa2, pa3);
        }
        if (pass == 0) ATT_PASS_REQ(1);
        if (hi == 0) li_l[r32] = l_reg;
        LDS_WAIT();
        float rli[16];
#pragma unroll
        for (int r = 0; r < 16; ++r) rli[r] = 1.0f / li_l[crow(r, hi)];
        __syncthreads();
        LAS unsigned char* stg = lds + (pass == 0 ? ATT_STG : 0);
#pragma unroll
        for (int r = 0; r < 16; ++r)
#pragma unroll
            for (int d0 = 0; d0 < 4; ++d0) *(LAS unsigned short*)(stg + crow(r, hi) * 2064 + (wid * 128 + 32 * d0 + r32) * 2) = (unsigned short)f2bf(o[d0][r] * rli[r]);
    }
#undef ATT_PASS_REQ
#undef ATT_TILE_LOAD
#undef ATT_TILE_LOAD_H
    __syncthreads();
#pragma unroll
    for (int tk = 0; tk < 4; ++tk) { const int token = 4 * wid + tk; const size_t row = (size_t)(rowbase + t0 + token); lane = opaque(lane);
        v4u x[4]; x[0] = *(const LAS v4u*)(lds + ATT_STG + token * 2064 + lane * 16); x[1] = *(const LAS v4u*)(lds + ATT_STG + token * 2064 + (lane + 64) * 16);
        x[2] = *(const LAS v4u*)(lds + token * 2064 + lane * 16); x[3] = *(const LAS v4u*)(lds + token * 2064 + (lane + 64) * 16);
        float s = 0.f;
#pragma unroll
        for (int i = 0; i < 4; ++i) { const float a0 = bflo(x[i].x), a1 = bfhi(x[i].x), a2 = bflo(x[i].y), a3 = bfhi(x[i].y), a4 = bflo(x[i].z), a5 = bfhi(x[i].z), a6 = bflo(x[i].w), a7 = bfhi(x[i].w);
            s += (a0 * a0 + a1 * a1) + (a2 * a2 + a3 * a3) + (a4 * a4 + a5 * a5) + (a6 * a6 + a7 * a7); }
        const float rs = 1.0f / sqrtf(wave_sum(s) * (1.0f / 2048.0f) + EPS);
#pragma unroll
        for (int i = 0; i < 4; ++i) { v4u w; w.x = pk2(bflo(x[i].x) * rs, bfhi(x[i].x) * rs); w.y = pk2(bflo(x[i].y) * rs, bfhi(x[i].y) * rs); w.z = pk2(bflo(x[i].z) * rs, bfhi(x[i].z) * rs); w.w = pk2(bflo(x[i].w) * rs, bfhi(x[i].w) * rs);
            *(v4u*)(MRG + tiled_idx((int)row, (i >> 1) * 1024 + (lane + 64 * (i & 1)) * 8, DM / 64)) = w; } }
    asm volatile("" ::: "memory");
    { LAS float* CSSQ = (LAS float*)(lds + ATT_WS_OFF);
      LAS float* CRS = CSSQ + 256;
      const int ch = 256 * wid + 4 * opaque(lane);
      const f32x4 w0 = *(const f32x4*)(wconv + ch), w1 = *(const f32x4*)(wconv + 2048 + ch), w2 = *(const f32x4*)(wconv + 4096 + ch);
      unsigned cpk[32][2];
      v2u c4[2][10], h4[2][10], g4[2][8];
#define CONV_LOAD(BT, SET) do { const int tb_ = t0 + 8 * (BT); \
          _Pragma("unroll") for (int r = 0; r < 10; ++r) { const int t = tb_ - 1 + r, tc = t < 0 ? 0 : (t >= L ? L - 1 : t); const bf16* zr = Z + (size_t)(rowbase + tc) * INW + ch; \
              c4[SET][r] = *(const v2u*)(zr + ZC); h4[SET][r] = *(const v2u*)(zr + ZH); } \
          _Pragma("unroll") for (int i = 0; i < 8; ++i) g4[SET][i] = *(const v2u*)(Z + (size_t)(rowbase + tb_ + i) * INW + ZB + ch); } while (0)
      CONV_LOAD(0, 0);
#pragma unroll
      for (int bt = 0; bt < 4; ++bt) { const int tb = t0 + 8 * bt, cs = bt & 1;
          if (bt < 3) CONV_LOAD(bt + 1, cs ^ 1);
          f32x4 u[10];
#pragma unroll
          for (int r = 0; r < 10; ++r) { const int t = tb - 1 + r; const float f = (t < 0 || t >= L) ? 0.f : 1.f;
              u[r] = (f32x4){bflo(c4[cs][r].x) * bflo(h4[cs][r].x), bfhi(c4[cs][r].x) * bfhi(h4[cs][r].x), bflo(c4[cs][r].y) * bflo(h4[cs][r].y), bfhi(c4[cs][r].y) * bfhi(h4[cs][r].y)} * f; }
#pragma unroll
          for (int i = 0; i < 8; ++i) { const f32x4 gb = {bflo(g4[cs][i].x), bfhi(g4[cs][i].x), bflo(g4[cs][i].y), bfhi(g4[cs][i].y)};
              const f32x4 c = gb * (w0 * u[i] + w1 * u[i + 1] + w2 * u[i + 2]);
              const unsigned p0 = pk2(c[0], c[1]), p1 = pk2(c[2], c[3]); cpk[8 * bt + i][0] = p0; cpk[8 * bt + i][1] = p1;
              const float r0 = bflo(p0), r1 = bfhi(p0), r2 = bflo(p1), r3 = bfhi(p1);
              const float sq = wave_sum((r0 * r0 + r1 * r1) + (r2 * r2 + r3 * r3));
              if (lane == 0) CSSQ[(8 * bt + i) * 8 + wid] = sq; }
          asm volatile("" ::: "memory"); }
#undef CONV_LOAD
      LDS_WAIT(); __syncthreads();
      if (tid < 32) { float s = 0.f;
#pragma unroll
          for (int w = 0; w < 8; ++w) s += CSSQ[tid * 8 + w];
          CRS[tid] = 1.0f / sqrtf(s * (1.0f / 2048.0f) + EPS); }
      LDS_WAIT(); __syncthreads();
#pragma unroll
      for (int i = 0; i < 32; ++i) { const float rs = CRS[i]; v2u w; w.x = pk2(bflo(cpk[i][0]) * rs, bfhi(cpk[i][0]) * rs); w.y = pk2(bflo(cpk[i][1]) * rs, bfhi(cpk[i][1]) * rs);
          *(v2u*)(MRG + tiled_idx(rowbase + t0 + i, 2048 + ch, DM / 64)) = w; } }
}
#undef KSWZ
#undef SBAR
}

struct Args { const float* in[22]; float* out; unsigned char* ws; int ph_lo, ph_hi; };
__global__ void __launch_bounds__(NWAVES * 64, 2) mk_fwd(Args args) {
    extern __shared__ __attribute__((aligned(16))) unsigned char lds_raw[];
    LAS unsigned char* lds = (LAS unsigned char*)lds_raw;
    volatile LAS unsigned* MISC = (volatile LAS unsigned*)(lds + MISC_OFF);
    const int tid = threadIdx.x, lane = tid & 63, wave = __builtin_amdgcn_readfirstlane(tid >> 6), G = gridDim.x;
    unsigned char* ws = args.ws;
    gu32* ctl = (gu32*)(ws + WS_CTL);
    const float* x_prompt = args.in[0]; const float* x_sample = args.in[1]; const float* cvec = args.in[2]; const float* cache_k = args.in[3]; const float* cache_v = args.in[4];
    const float* c_ctx = args.in[5]; const float* w_mod = args.in[6]; const float* b_mod = args.in[7]; const float* g_pre = args.in[8]; const float* g_post = args.in[9];
    const float* w_in = args.in[10]; const float* w_conv = args.in[11]; const float* sink = args.in[12]; const float* g_attn = args.in[13]; const float* g_conv = args.in[14];
    const float* w_o = args.in[15]; const float* wg1 = args.in[16]; const float* wu1 = args.in[17]; const float* wd1 = args.in[18];
    const float* wg2 = args.in[19]; const float* wu2 = args.in[20]; const float* wd2 = args.in[21];
    float* out = args.out; float* state_k = out + (size_t)2 * NCTX * DM; float* state_v = state_k + (size_t)NCTX * 512;
    float* MOD = (float*)(ws + WS_MOD); float* ROPE = (float*)(ws + WS_ROPE); bf16* CK = (bf16*)(ws + WS_CK); bf16* CV = (bf16*)(ws + WS_CV);
    bf16* WGU1 = (bf16*)(ws + WS_WGU1); bf16* WD1 = (bf16*)(ws + WS_WD1); bf16* WIN = (bf16*)(ws + WS_WIN); bf16* WO = (bf16*)(ws + WS_WO); bf16* WGU2 = (bf16*)(ws + WS_WGU2); bf16* WD2 = (bf16*)(ws + WS_WD2);
    bf16* U = (bf16*)(ws + WS_U); bf16* MRG = (bf16*)(ws + WS_MRG); bf16* ACT = (bf16*)(ws + WS_ACT); bf16* Ob = (bf16*)(ws + WS_O); bf16* Hb = (bf16*)(ws + WS_H); bf16* Z = (bf16*)(ws + WS_Z);

    for (int u = tid; u < (LDS_BYTES - LDSCTL_OFF) / 4; u += NWAVES * 64) ((LAS unsigned*)(lds + LDSCTL_OFF))[u] = 0u;
    __syncthreads();
    XcdBarrier bar; bar.bar = (unsigned*)(ctl + CW_BAR); bar.x = 0; bar.st = nullptr;
    if (N_LAUNCHES != NPHASE) bar = xcd_barrier_post((unsigned*)(ctl + CW_BAR), MISC + 8);
#define GRID_BAR() do { if (N_LAUNCHES != NPHASE) xcd_barrier(bar); } while (0)
    const int lo = args.ph_lo, hi = args.ph_hi;
#define IN(k) (lo <= (k) && (k) < hi)
#define BOTH(k) (IN(k) && IN((k) + 1))
    const int gw = blockIdx.x * NWAVES + wave, NGW = G * NWAVES;
    const P0Args A{cvec, cache_k, cache_v, c_ctx, w_mod, b_mod, w_in, g_attn, g_conv, w_o, wg1, wu1, wd1, wg2, wu2, wd2, MOD, ROPE, CK, CV, WGU1, WD1, WIN, WO, WGU2, WD2};

    if (IN(0)) {
        phase0(lds, A, tid, wave, lane, G);
        if (BOTH(0)) GRID_BAR();
    }
    if (IN(1)) {
        rows_pre(lds, x_prompt, x_sample, MOD, g_pre + 0 * DM, U, tid, wave, lane, G);
        if (BOTH(1)) GRID_BAR();
    }
    if (IN(2)) {
        pg8::Gemm g{U, WGU1, NTOK, 2 * DFF, DM}; pg8::StaticOrder S; S.init(NTOK, 2 * DFF, G, (int)blockIdx.x);
        pg8::EpiSwiGLU E{ACT, DFF / 64};
        pg8::gemm_phase<pg8::EpiSwiGLU, pg8::StaticOrder, false, true, true, true>(lds, g, S, E);
        tail_convert(lds, A, wave, lane, G, (NTOK / 256) * (2 * DFF / 256), CI_P0_END, CI_WD1_END);
        if (BOTH(2)) GRID_BAR();
    }
    if (IN(3)) {
        pg8::Gemm g{ACT, WD1, NTOK, DM, DFF}; pg8::HalfMOrder S; S.init(NTOK, DM, G, (int)blockIdx.x);
        pg8::EpiBf16 E{Ob, DM};
        pg8::gemm_phase<pg8::EpiBf16, pg8::HalfMOrder, true, true, true, true>(lds, g, S, E);
        if (BOTH(3)) GRID_BAR();
    }
    if (IN(4)) {
        rows_post_pre<true, true, 0>(lds, x_prompt, x_sample, Hb, Ob, MOD, 0.5f, g_post + 0 * DM, nullptr, g_pre + 1 * DM, U, tid, wave, lane, G);
        if (BOTH(4)) GRID_BAR();
    }
    if (IN(5)) {
        pg8::Gemm g{U, WIN, NTOK, INW, DM}; pg8::StaticOrder S; S.init(NTOK, INW, G, (int)blockIdx.x);
        pg8::EpiInProj E{Z, ROPE, state_k, state_v};
        pg8::gemm_phase<pg8::EpiInProj, pg8::StaticOrder, true, true, true, true>(lds, g, S, E);
        tail_convert(lds, A, wave, lane, G, (NTOK / 256) * (INW / 256), CI_WD1_END, CI_X1);
        if (BOTH(5)) GRID_BAR();
    }
    if (IN(6)) {
        for (int unit = blockIdx.x; unit < 256; unit += G) att::attn_conv_unit(lds, unit, Z, CK, CV, sink, w_conv, MRG, tid, wave, lane);
        if (G == 256) { if (blockIdx.x < 128) convert_items(lds, A, wave, lane, CI_X1, CI_X2, (int)blockIdx.x * NWAVES + wave, 128 * NWAVES); }
        else convert_items(lds, A, wave, lane, CI_X1, CI_X2, (int)blockIdx.x * NWAVES + wave, G * NWAVES);
        if (BOTH(6)) GRID_BAR();
    }
    if (IN(7)) {
        pg8::Gemm g{MRG, WO, NTOK, DM, DM}; pg8::StaticOrder S; S.init(NTOK, DM, G, (int)blockIdx.x);
        pg8::EpiBf16 E{Ob, DM};
        pg8::gemm_phase<pg8::EpiBf16, pg8::StaticOrder, true, true, true, true>(lds, g, S, E);
        if (BOTH(7)) GRID_BAR();
    }
    if (IN(8)) {
        rows_post_pre<true, false, 1>(lds, x_prompt, x_sample, Hb, Ob, MOD, 1.0f, g_post + 1 * DM, nullptr, g_pre + 2 * DM, U, tid, wave, lane, G);
        if (BOTH(8)) GRID_BAR();
    }
    if (IN(9)) {
        pg8::Gemm g{U, WGU2, NTOK, 2 * DFF, DM}; pg8::StaticOrder S; S.init(NTOK, 2 * DFF, G, (int)blockIdx.x);
        pg8::EpiSwiGLU E{ACT, DFF / 64};
        pg8::gemm_phase<pg8::EpiSwiGLU, pg8::StaticOrder, false, true, true, true>(lds, g, S, E);
        tail_convert(lds, A, wave, lane, G, (NTOK / 256) * (2 * DFF / 256), CI_X2, CI_END);
        if (BOTH(9)) GRID_BAR();
    }
    if (IN(10)) {
        pg8::Gemm g{ACT, WD2, NTOK, DM, DFF}; pg8::HalfMOrder S; S.init(NTOK, DM, G, (int)blockIdx.x);
        pg8::EpiBf16 E{Ob, DM};
        pg8::gemm_phase<pg8::EpiBf16, pg8::HalfMOrder, true, true, true, true>(lds, g, S, E);
        if (BOTH(10)) GRID_BAR();
    }
    if (IN(11)) {
        rows_post_pre<false, false, 2>(lds, x_prompt, x_sample, Hb, Ob, MOD, 0.5f, g_post + 2 * DM, out, nullptr, nullptr, tid, wave, lane, G);
    }
#undef IN
#undef BOTH
#undef GRID_BAR
}

extern "C" void kernel_launch(void* const* d_in, const int* in_sizes, int n_in, void* d_out, int out_size, void* d_ws, size_t ws_size, hipStream_t stream) {
    static int grid = 0;
    if (grid == 0) {
        if (n_in != 22 || ws_size < WS_END) { fprintf(stderr, "kernel_launch: expected 22 inputs and >= %zu bytes of workspace; got %d inputs, %zu bytes\n", (size_t)WS_END, n_in, ws_size); grid = -1; return; }
        int dev = 0, cus = 0, per_cu = 0;
        if (hipGetDevice(&dev) != hipSuccess || hipDeviceGetAttribute(&cus, hipDeviceAttributeMultiprocessorCount, dev) != hipSuccess) { fprintf(stderr, "kernel_launch: device query failed\n"); grid = -1; return; }
        if (hipFuncSetAttribute((const void*)mk_fwd, hipFuncAttributeMaxDynamicSharedMemorySize, LDS_BYTES) != hipSuccess) { fprintf(stderr, "kernel_launch: hipFuncSetAttribute failed\n"); grid = -1; return; }
        if (hipOccupancyMaxActiveBlocksPerMultiprocessor(&per_cu, (const void*)mk_fwd, NWAVES * 64, LDS_BYTES) != hipSuccess || per_cu < 1)
            fprintf(stderr, "kernel_launch: note: occupancy query reports %d workgroups per CU\n", per_cu);
        (void)hipGetLastError();
        grid = cus;
    }
    if (grid < 0) return;
    if (hipMemsetAsync((char*)d_ws + WS_CTL, 0, CTL_ZERO_BYTES, stream) != hipSuccess) { fprintf(stderr, "kernel_launch: memset failed\n"); return; }
    Args a{};
    for (int i = 0; i < 22; ++i) a.in[i] = (const float*)d_in[i];
    a.out = (float*)d_out; a.ws = (unsigned char*)d_ws;
    const int nl = (N_LAUNCHES == NPHASE) ? NPHASE : 1;
    for (int li = 0; li < nl; ++li) {
        a.ph_lo = (N_LAUNCHES == NPHASE) ? li : 0; a.ph_hi = (N_LAUNCHES == NPHASE) ? li + 1 : NPHASE;
        hipLaunchKernelGGL(mk_fwd, dim3(grid), dim3(NWAVES * 64), LDS_BYTES, stream, a);
        const hipError_t le = hipPeekAtLastError();
        if (le != hipSuccess) { fprintf(stderr, "kernel_launch: launch %d failed: %s\n", li, hipGetErrorName(le)); break; }
    }
}
```

```cpp
#include <hip/hip_runtime.h>
#include <cstdio>
#include <cstdint>
#define MK_N_LAUNCHES 1
namespace pg8 {
#define PG8_LAS __attribute__((address_space(3)))
typedef unsigned short bf16_t;
typedef short bf16x8 __attribute__((ext_vector_type(8)));
typedef float f32x4 __attribute__((ext_vector_type(4)));
typedef unsigned u32x4 __attribute__((ext_vector_type(4)));
constexpr int BM = 256, BK = 64, HALF = 128, HTB = HALF * BK * 2  , STAGE_BYTES = 8 * HTB, NXCD = 8, WGM = 8;

__host__ __device__ __forceinline__ int lds_byte(int r, int c) { const int st = (r >> 4) * 2 + (c >> 5), rr = r & 15, cc = c & 31, ob = rr * 64 + cc * 2; return st * 1024 + (ob ^ (((ob >> 9) & 1) << 5)); }
__host__ __device__ __forceinline__ void stage_rc(int b, int& R, int& C) { const int st = b / 1024, sb = b % 1024, swz = sb ^ (((sb >> 9) & 1) << 5); R = (st >> 1) * 16 + swz / 64; C = (st & 1) * 32 + (swz % 64) / 2; }
__host__ __device__ __forceinline__ int perm32(int rho) { const int n = rho >> 4, i = rho & 15; return 8 * (i >> 2) + 4 * n + (i & 3); }

struct Unit { int pm, pn; };
struct Gemm { const bf16_t* A; const bf16_t* Bt; int M, N, K; };

struct StaticOrder {
    int nM, nN, nwg, G, c;
    __host__ __device__ void init(int M, int N, int G_, int c_) { nM = M / BM; nN = N / BM; nwg = nM * nN; G = G_; c = c_; }
    __host__ __device__ bool next(int i, Unit& u) const {
        const long L = (long)i * G + c; if (L >= nwg) return false;
        int wgid = (int)L; { const int q = nwg / NXCD, r = nwg % NXCD, xcd = wgid % NXCD, off = wgid / NXCD; wgid = (xcd < r ? xcd * (q + 1) : r * (q + 1) + (xcd - r) * q) + off; }
        const int nig = WGM * nN, gid = wgid / nig, fm = gid * WGM, gsz = (nM - fm) < WGM ? (nM - fm) : WGM;
        u.pm = fm + ((wgid % nig) % gsz); u.pn = (wgid % nig) / gsz; return true;
    }
    __device__ __forceinline__ void a_ready(const Unit&) const {}
    __device__ __forceinline__ void done(const Unit&) const {}
};

struct HalfMOrder : StaticOrder {
    __host__ __device__ bool next(int i, Unit& u) const {
        if (!(nM == 32 && nN == 16 && G == 256)) return StaticOrder::next(i, u);
        if (i >= 2) return false;
        const int xcd = c & 7, slot = c >> 3;
        u.pm = 16 * i + 8 * (xcd >> 2) + (slot & 7); u.pn = 4 * (xcd & 3) + (slot >> 3); return true;
    }
};

__device__ __forceinline__ unsigned cvt_pk_bf16(float lo, float hi) { unsigned r; asm volatile("v_cvt_pk_bf16_f32 %0, %1, %2" : "=v"(r) : "v"(lo), "v"(hi)); return r; }
__device__ __forceinline__ float silu_f(float x) { return x * __builtin_amdgcn_rcpf(1.0f + __builtin_amdgcn_exp2f(-1.4426950408889634f * x)); }

struct EpiBf16 {
    static constexpr bool PERM = true, AFTER_DRAIN = false;
    bf16_t* O; int ldc;
    __device__ __forceinline__ void operator()(const f32x4 (&acc)[2][2][4][2], const Unit& u, int wr, int wc, int fr, int fq) const {
        const int row0 = u.pm * BM + wr * 64 + fr, col0 = u.pn * BM + wc * 32 + 8 * fq;
#pragma unroll
        for (int ai = 0; ai < 2; ++ai)
#pragma unroll
            for (int m = 0; m < 4; ++m) { bf16_t* rowp = O + (size_t)(row0 + ai * HALF + m * 16) * ldc + col0;
#pragma unroll
                for (int bj = 0; bj < 2; ++bj) { const f32x4 v0 = acc[ai][bj][m][0], v1 = acc[ai][bj][m][1];
                    u32x4 w; w.x = cvt_pk_bf16(v0[0], v0[1]); w.y = cvt_pk_bf16(v0[2], v0[3]); w.z = cvt_pk_bf16(v1[0], v1[1]); w.w = cvt_pk_bf16(v1[2], v1[3]);
                    *(u32x4*)(rowp + bj * HALF) = w; } }
    }
};
struct EpiSwiGLU {
    static constexpr bool PERM = true, AFTER_DRAIN = false;
    bf16_t* O; int kt_out;
    __device__ __forceinline__ void operator()(const f32x4 (&acc)[2][2][4][2], const Unit& u, int wr, int wc, int fr, int fq) const {
        const int r0 = wr * 64 + fr, col0 = u.pn * HALF + wc * 32 + 8 * fq;
        bf16_t* base = O + ((size_t)u.pm * kt_out + (col0 >> 6)) * 16384 + (col0 & 63);
#pragma unroll
        for (int ai = 0; ai < 2; ++ai)
#pragma unroll
            for (int m = 0; m < 4; ++m) { bf16_t* rowp = base + (r0 + ai * HALF + m * 16) * 64;
                const f32x4 g0 = acc[ai][0][m][0], g1 = acc[ai][0][m][1], u0 = acc[ai][1][m][0], u1 = acc[ai][1][m][1];
                u32x4 w;
                w.x = cvt_pk_bf16(silu_f(g0[0]) * u0[0], silu_f(g0[1]) * u0[1]); w.y = cvt_pk_bf16(silu_f(g0[2]) * u0[2], silu_f(g0[3]) * u0[3]);
                w.z = cvt_pk_bf16(silu_f(g1[0]) * u1[0], silu_f(g1[1]) * u1[1]); w.w = cvt_pk_bf16(silu_f(g1[2]) * u1[2], silu_f(g1[3]) * u1[3]);
                *(u32x4*)rowp = w; }
    }
};
struct EpiInProj {
    static constexpr bool PERM = true, AFTER_DRAIN = false;
    bf16_t* Z; const float* rope; float* state_k; float* state_v;
    __device__ __forceinline__ void operator()(const f32x4 (&acc)[2][2][4][2], const Unit& u, int wr, int wc, int fr, int fq) const {
        const int row0 = u.pm * BM + wr * 64 + fr;
        if (u.pn < 10) {
            const bool isk = u.pn >= 8; const int rb = isk ? 2048 : 0, tl = isk ? u.pn - 8 : u.pn;
            const int hh = wc >> 1, axis = wc & 1, i0 = 8 * fq;
            const int ncol = rb + (2 * tl + hh) * 128 + 64 * axis + i0;
            const bool lat = u.pm >= 16;
#pragma unroll
            for (int ai = 0; ai < 2; ++ai)
#pragma unroll
                for (int m = 0; m < 4; ++m) { const int row = row0 + ai * HALF + m * 16;
                    f32x4 a0 = acc[ai][0][m][0], a1 = acc[ai][0][m][1], b0 = acc[ai][1][m][0], b1 = acc[ai][1][m][1];
                    if (lat) { const int t = (row - 4096) & 2047, pos = axis ? (t & 63) : (t >> 6);
                        const f32x4* tp = (const f32x4*)(rope + ((size_t)pos * 32 + i0) * 2);
                        const f32x4 c01 = tp[0], c23 = tp[1], c45 = tp[2], c67 = tp[3];
                        f32x4 r0, r1, s0, s1;
                        r0[0] = a0[0] * c01[0] - b0[0] * c01[1]; s0[0] = b0[0] * c01[0] + a0[0] * c01[1];
                        r0[1] = a0[1] * c01[2] - b0[1] * c01[3]; s0[1] = b0[1] * c01[2] + a0[1] * c01[3];
                        r0[2] = a0[2] * c23[0] - b0[2] * c23[1]; s0[2] = b0[2] * c23[0] + a0[2] * c23[1];
                        r0[3] = a0[3] * c23[2] - b0[3] * c23[3]; s0[3] = b0[3] * c23[2] + a0[3] * c23[3];
                        r1[0] = a1[0] * c45[0] - b1[0] * c45[1]; s1[0] = b1[0] * c45[0] + a1[0] * c45[1];
                        r1[1] = a1[1] * c45[2] - b1[1] * c45[3]; s1[1] = b1[1] * c45[2] + a1[1] * c45[3];
                        r1[2] = a1[2] * c67[0] - b1[2] * c67[1]; s1[2] = b1[2] * c67[0] + a1[2] * c67[1];
                        r1[3] = a1[3] * c67[2] - b1[3] * c67[3]; s1[3] = b1[3] * c67[2] + a1[3] * c67[3];
                        a0 = r0; a1 = r1; b0 = s0; b1 = s1; }
                    bf16_t* zp = Z + (size_t)row * 9216 + ncol;
                    u32x4 w1, w2; w1.x = cvt_pk_bf16(a0[0], a0[1]); w1.y = cvt_pk_bf16(a0[2], a0[3]); w1.z = cvt_pk_bf16(a1[0], a1[1]); w1.w = cvt_pk_bf16(a1[2], a1[3]);
                    w2.x = cvt_pk_bf16(b0[0], b0[1]); w2.y = cvt_pk_bf16(b0[2], b0[3]); w2.z = cvt_pk_bf16(b1[0], b1[1]); w2.w = cvt_pk_bf16(b1[2], b1[3]);
                    *(u32x4*)zp = w1; *(u32x4*)(zp + 32) = w2;
                    if (isk && !lat) { float* sp = state_k + (size_t)row * 512 + (ncol - 2048);
                        *(f32x4*)sp = a0; *(f32x4*)(sp + 4) = a1; *(f32x4*)(sp + 32) = b0; *(f32x4*)(sp + 36) = b1; } }
        } else {
            const int col0 = u.pn * BM + wc * 32 + 8 * fq; const bool isv = u.pn < 12, ctx = u.pm < 16;
#pragma unroll
            for (int ai = 0; ai < 2; ++ai)
#pragma unroll
                for (int m = 0; m < 4; ++m) { const int row = row0 + ai * HALF + m * 16; bf16_t* zp = Z + (size_t)row * 9216 + col0;
#pragma unroll
                    for (int bj = 0; bj < 2; ++bj) { const f32x4 v0 = acc[ai][bj][m][0], v1 = acc[ai][bj][m][1];
                        u32x4 w; w.x = cvt_pk_bf16(v0[0], v0[1]); w.y = cvt_pk_bf16(v0[2], v0[3]); w.z = cvt_pk_bf16(v1[0], v1[1]); w.w = cvt_pk_bf16(v1[2], v1[3]);
                        *(u32x4*)(zp + bj * HALF) = w;
                        if (isv && ctx) { float* sp = state_v + (size_t)row * 512 + (col0 - 2560) + bj * HALF; *(f32x4*)sp = v0; *(f32x4*)(sp + 4) = v1; } } }
        }
    }
};

template <class Epi, class Sched, bool ALIGN_EPI = false, bool SP2 = false, bool TA = false, bool TB = false>
__device__ __forceinline__ void gemm_phase(PG8_LAS unsigned char* lds, const Gemm g, const Sched& S, const Epi& E) {
    const int tid = threadIdx.x, wid = __builtin_amdgcn_readfirstlane(tid >> 6), lane = tid & 63, wr = wid >> 2, wc = wid & 3, fr = lane & 15, fq = lane >> 4;
    const int K = g.K, nt = K / BK;
    unsigned voffA[2], voffB[2];
#pragma unroll
    for (int i = 0; i < 2; ++i) { int R, C; stage_rc(tid * 16 + i * 8192, R, C); const int Rb = Epi::PERM ? ((R & ~31) + perm32(R & 31)) : R;
        voffA[i] = TA ? (unsigned)(R * BK + C) * 2u : (unsigned)(R * K + C) * 2u; voffB[i] = TB ? (unsigned)(Rb * BK + C) * 2u : (unsigned)(Rb * K + C) * 2u; }
    const size_t kstepA = TA ? (size_t)(BM * BK * 2) : (size_t)(BK * 2), kstepB = TB ? (size_t)(BM * BK * 2) : (size_t)(BK * 2);
    const size_t hstepA = TA ? (size_t)(HALF * BK * 2) : (size_t)HALF * K * 2, hstepB = TB ? (size_t)(HALF * BK * 2) : (size_t)HALF * K * 2;
    const size_t tstepA = (size_t)BM * K * 2, tstepB = (size_t)BM * K * 2;
    const unsigned ldsw = (unsigned)wid * 1024u;
    const int aoff = lds_byte(wr * 64 + fr, fq * 8), boff = lds_byte(wc * 32 + fr, fq * 8);
#define PG8_SA(b, h) (((b) * 2 + (h)) * HTB)
#define PG8_SB(b, h) ((4 + (b) * 2 + (h)) * HTB)
#define PG8_STAGE(bufoff, gbase, voff) do { _Pragma("unroll") for (int _i = 0; _i < 2; ++_i) \
        __builtin_amdgcn_global_load_lds((const unsigned*)((const char*)(gbase) + (voff)[_i]), (PG8_LAS unsigned*)(lds + (bufoff) + ldsw + _i * 8192), 16, 0, 0); } while (0)
#define PG8_LDA(dst, b, h) do { _Pragma("unroll") for (int m = 0; m < 4; ++m) _Pragma("unroll") for (int k = 0; k < 2; ++k) dst[m][k] = *(const PG8_LAS bf16x8*)(lds + PG8_SA(b, h) + aoff + m * 2048 + k * 1024); } while (0)
#define PG8_LDB(dst, b, h) do { _Pragma("unroll") for (int n = 0; n < 2; ++n) _Pragma("unroll") for (int k = 0; k < 2; ++k) dst[n][k] = *(const PG8_LAS bf16x8*)(lds + PG8_SB(b, h) + boff + n * 2048 + k * 1024); } while (0)
#define PG8_MMA(ai, bj, At, Bt) do { __builtin_amdgcn_s_setprio(1); _Pragma("unroll") for (int m = 0; m < 4; ++m) _Pragma("unroll") for (int n = 0; n < 2; ++n) _Pragma("unroll") for (int k = 0; k < 2; ++k) \
        acc[ai][bj][m][n] = __builtin_amdgcn_mfma_f32_16x16x32_bf16(Bt[n][k], At[m][k], acc[ai][bj][m][n], 0, 0, 0); __builtin_amdgcn_s_setprio(0); } while (0)
#define PG8_WAIT_V(n) asm volatile("s_waitcnt vmcnt(" #n ")" ::: "memory")
#define PG8_WAIT_L(n) asm volatile("s_waitcnt lgkmcnt(" #n ")" ::: "memory")
#define PG8_BAR __builtin_amdgcn_s_barrier()
#define PG8_SCHED __builtin_amdgcn_sched_barrier(0)
    Unit cur, nxt; int ui = 0;
    if (!S.next(0, cur)) return;
    f32x4 acc[2][2][4][2];
#pragma unroll
    for (int a = 0; a < 2; ++a)
#pragma unroll
        for (int b = 0; b < 2; ++b)
#pragma unroll
            for (int m = 0; m < 4; ++m)
#pragma unroll
                for (int n = 0; n < 2; ++n) acc[a][b][m][n] = (f32x4){0.f, 0.f, 0.f, 0.f};
    bf16x8 At[4][2], B0[2][2], B1[2][2];
    const char* cA = (const char*)g.A + (size_t)cur.pm * tstepA; const char* cB = (const char*)g.Bt + (size_t)cur.pn * tstepB;
    S.a_ready(cur);
    if constexpr (SP2) {
        PG8_STAGE(PG8_SB(0, 0), cB, voffB); PG8_STAGE(PG8_SB(0, 1), cB + hstepB, voffB); PG8_STAGE(PG8_SA(0, 0), cA, voffA); PG8_STAGE(PG8_SA(0, 1), cA + hstepA, voffA);
        if (wr == 1) PG8_BAR;
        PG8_WAIT_V(2); PG8_BAR;
        PG8_STAGE(PG8_SB(1, 0), cB + kstepB, voffB); PG8_STAGE(PG8_SA(1, 0), cA + kstepA, voffA); PG8_STAGE(PG8_SB(1, 1), cB + hstepB + kstepB, voffB);
        PG8_WAIT_V(6); PG8_BAR;
    } else {
        PG8_STAGE(PG8_SB(0, 0), cB, voffB); PG8_STAGE(PG8_SA(0, 0), cA, voffA); PG8_STAGE(PG8_SB(0, 1), cB + hstepB, voffB); PG8_STAGE(PG8_SA(0, 1), cA + hstepA, voffA);
        if (wr == 1) PG8_BAR;
        PG8_WAIT_V(4); PG8_BAR;
        PG8_STAGE(PG8_SB(1, 0), cB + kstepB, voffB); PG8_STAGE(PG8_SA(1, 0), cA + kstepA, voffA); PG8_STAGE(PG8_SB(1, 1), cB + hstepB + kstepB, voffB);
        PG8_WAIT_V(6); PG8_BAR;
    }
    for (;;) {
        const bool has_next = S.next(ui + 1, nxt);
        const char* nA = has_next ? (const char*)g.A + (size_t)nxt.pm * tstepA : cA; const char* nB = has_next ? (const char*)g.Bt + (size_t)nxt.pn * tstepB : cB;
        for (int t = 0; t < nt; t += 2) {
            const bool last = (t == nt - 2);
            const char* a1 = cA + (size_t)(t + 1) * kstepA;
            const char* a2 = last ? nA : cA + (size_t)(t + 2) * kstepA; const char* b2 = last ? nB : cB + (size_t)(t + 2) * kstepB;
            const char* a3 = a2 + kstepA; const char* b3 = b2 + kstepB;
            if (last && has_next) S.a_ready(nxt);
            if constexpr (SP2) {
            PG8_LDB(B0, 0, 0); PG8_LDB(B1, 0, 1); PG8_SCHED; PG8_LDA(At, 0, 0); PG8_STAGE(PG8_SA(1, 1), a1 + hstepA, voffA);
            PG8_WAIT_V(8); PG8_WAIT_L(0); PG8_BAR; PG8_MMA(0, 0, At, B0); PG8_MMA(0, 1, At, B1); PG8_BAR; PG8_SCHED;
            PG8_LDA(At, 0, 1); PG8_STAGE(PG8_SB(0, 0), b2, voffB); PG8_STAGE(PG8_SB(0, 1), b2 + hstepB, voffB); PG8_STAGE(PG8_SA(0, 0), a2, voffA);
            PG8_WAIT_V(8); PG8_WAIT_L(0); PG8_BAR; PG8_MMA(1, 0, At, B0); PG8_MMA(1, 1, At, B1); PG8_BAR; PG8_SCHED;
            PG8_LDB(B0, 1, 0); PG8_LDB(B1, 1, 1); PG8_SCHED; PG8_LDA(At, 1, 0); PG8_STAGE(PG8_SA(0, 1), a2 + hstepA, voffA);
            PG8_WAIT_V(8); PG8_WAIT_L(0); PG8_BAR; PG8_MMA(0, 0, At, B0); PG8_MMA(0, 1, At, B1); PG8_BAR; PG8_SCHED;
            PG8_LDA(At, 1, 1); PG8_STAGE(PG8_SB(1, 0), b3, voffB); PG8_STAGE(PG8_SB(1, 1), b3 + hstepB, voffB); PG8_STAGE(PG8_SA(1, 0), a3, voffA);
            PG8_WAIT_V(8); PG8_WAIT_L(0); PG8_BAR; PG8_MMA(1, 0, At, B0); PG8_MMA(1, 1, At, B1); PG8_BAR; PG8_SCHED;
            } else {
            PG8_LDB(B0, 0, 0); PG8_SCHED; PG8_LDA(At, 0, 0); PG8_STAGE(PG8_SA(1, 1), a1 + hstepA, voffA);
            PG8_WAIT_L(8); PG8_BAR; PG8_WAIT_L(0); PG8_MMA(0, 0, At, B0); PG8_BAR; PG8_SCHED;
            PG8_LDB(B1, 0, 1); PG8_STAGE(PG8_SB(0, 0), b2, voffB);
            PG8_BAR; PG8_WAIT_L(0); PG8_MMA(0, 1, At, B1); PG8_BAR;
            PG8_LDA(At, 0, 1); PG8_STAGE(PG8_SA(0, 0), a2, voffA);
            PG8_BAR; PG8_WAIT_L(0); PG8_MMA(1, 0, At, B0); PG8_BAR; PG8_SCHED;
            PG8_STAGE(PG8_SB(0, 1), b2 + hstepB, voffB);
            PG8_WAIT_V(6); PG8_BAR; PG8_MMA(1, 1, At, B1); PG8_BAR;
            PG8_LDB(B0, 1, 0); PG8_SCHED; PG8_LDA(At, 1, 0); PG8_STAGE(PG8_SA(0, 1), a2 + hstepA, voffA);
            PG8_WAIT_L(8); PG8_BAR; PG8_WAIT_L(0); PG8_MMA(0, 0, At, B0); PG8_BAR; PG8_SCHED;
            PG8_LDB(B1, 1, 1); PG8_STAGE(PG8_SB(1, 0), b3, voffB);
            PG8_BAR; PG8_WAIT_L(0); PG8_MMA(0, 1, At, B1); PG8_BAR;
            PG8_LDA(At, 1, 1); PG8_STAGE(PG8_SA(1, 0), a3, voffA);
            PG8_BAR; PG8_WAIT_L(0); PG8_MMA(1, 0, At, B0); PG8_BAR; PG8_SCHED;
            PG8_STAGE(PG8_SB(1, 1), b3 + hstepB, voffB);
            PG8_WAIT_V(6); PG8_BAR; PG8_MMA(1, 1, At, B1); PG8_BAR;
            }
        }
        if constexpr (ALIGN_EPI) { if (wr == 0) PG8_BAR; }
        if constexpr (!Epi::AFTER_DRAIN) { E(acc, cur, wr, wc, fr, fq); S.done(cur); }
        if (!has_next) break;
#pragma unroll
        for (int a = 0; a < 2; ++a)
#pragma unroll
            for (int b = 0; b < 2; ++b)
#pragma unroll
                for (int m = 0; m < 4; ++m)
#pragma unroll
                    for (int n = 0; n < 2; ++n) acc[a][b][m][n] = (f32x4){0.f, 0.f, 0.f, 0.f};
        cur = nxt; cA = nA; cB = nB; ++ui;
        if constexpr (ALIGN_EPI) { if (wr == 1) PG8_BAR; }
    }
    PG8_WAIT_V(0);
    if constexpr (!ALIGN_EPI) { if (wr == 0) PG8_BAR; }
    PG8_BAR;
    if constexpr (Epi::AFTER_DRAIN) { E.fused(acc, cur, wr, wc, fr, fq, lds, wid, lane); S.done(cur); }
#undef PG8_SA
#undef PG8_SB
#undef PG8_STAGE
#undef PG8_LDA
#undef PG8_LDB
#undef PG8_MMA
#undef PG8_WAIT_V
#undef PG8_WAIT_L
#undef PG8_BAR
#undef PG8_SCHED
}
}

constexpr int NWAVES = 8;
#ifndef MK_N_LAUNCHES
#define MK_N_LAUNCHES 1
#endif
constexpr int N_LAUNCHES = MK_N_LAUNCHES;
constexpr int NPHASE = 12;

constexpr int DM = 4096, DFF = 11008, NTOK = 8192, NCTX = 4096, LAT_T = 2048, CTX_T = 256, INW = 9216, MODW = 36864;
constexpr int ZK = 2048, ZV = 2560, ZB = 3072, ZC = 5120, ZH = 7168;
constexpr float EPS = 1e-6f;

constexpr size_t MiB = 1u << 20;
constexpr size_t WS_CTL = 0, CTL_ZERO_BYTES = 1 * MiB;
constexpr size_t WS_MOD = 1 * MiB, WS_ROPE = 2 * MiB, WS_CK = 3 * MiB, WS_CV = 3 * MiB + 512 * 1024;
constexpr size_t WS_WGU1 = 4 * MiB, WS_WD1 = 176 * MiB, WS_WIN = 262 * MiB, WS_WO = 334 * MiB, WS_WGU2 = 366 * MiB, WS_WD2 = 538 * MiB;
constexpr size_t WS_U = 624 * MiB, WS_MRG = 688 * MiB, WS_ACT = 752 * MiB, WS_O = 924 * MiB, WS_H = 1052 * MiB, WS_Z = 1180 * MiB, WS_END = 1324 * MiB;
constexpr int CW_BAR = 4096;

constexpr int RING_BYTES = 131072;
constexpr int ATT_STG = 32 * 2064;
constexpr int ATT_WS_OFF = 2 * ATT_STG;
constexpr int LDSCTL_OFF = ATT_WS_OFF + 2048;
constexpr int MISC_OFF = LDSCTL_OFF + 64;
constexpr int LDS_BYTES = 135168;
static_assert(MISC_OFF + 64 <= LDS_BYTES, "LDS map");

#define GAS __attribute__((address_space(1)))
#define LAS __attribute__((address_space(3)))
typedef unsigned short bf16;
typedef unsigned v4u __attribute__((ext_vector_type(4)));
typedef unsigned v2u __attribute__((ext_vector_type(2)));
typedef float f32x4 __attribute__((ext_vector_type(4)));
typedef float f32x2 __attribute__((ext_vector_type(2)));
typedef short bf16x8 __attribute__((ext_vector_type(8)));
typedef short s16x4 __attribute__((ext_vector_type(4)));
typedef float f32x16 __attribute__((ext_vector_type(16)));
typedef GAS unsigned gu32;
#define RLX_AGENT __ATOMIC_RELAXED, __HIP_MEMORY_SCOPE_AGENT
#define LDS_WAIT() asm volatile("s_waitcnt lgkmcnt(0)" ::: "memory")
#define VM_WAIT() asm volatile("s_waitcnt vmcnt(0)" ::: "memory")
__device__ __forceinline__ unsigned f2bf(float f) { unsigned u = __builtin_bit_cast(unsigned, f); return (u + 0x7fffu + ((u >> 16) & 1u)) >> 16; }
__device__ __forceinline__ unsigned pk2(float lo, float hi) { return f2bf(lo) | (f2bf(hi) << 16); }
__device__ __forceinline__ float bflo(unsigned w) { return __builtin_bit_cast(float, w << 16); }
__device__ __forceinline__ float bfhi(unsigned w) { return __builtin_bit_cast(float, w & 0xffff0000u); }
template <int CTRL> __device__ __forceinline__ float dpp_f(float v) { return __builtin_bit_cast(float, __builtin_amdgcn_update_dpp(0, __builtin_bit_cast(int, v), CTRL, 0xf, 0xf, true)); }
__device__ __forceinline__ float wave_sum(float v) {
    v += dpp_f<0xB1>(v); v += dpp_f<0x4E>(v); v += dpp_f<0x141>(v); v += dpp_f<0x140>(v);
    const int b = __builtin_bit_cast(int, v);
    return (__builtin_bit_cast(float, __builtin_amdgcn_readlane(b, 0)) + __builtin_bit_cast(float, __builtin_amdgcn_readlane(b, 16))) +
           (__builtin_bit_cast(float, __builtin_amdgcn_readlane(b, 32)) + __builtin_bit_cast(float, __builtin_amdgcn_readlane(b, 48)));
}
__device__ __forceinline__ int opaque(int v) { asm volatile("" : "+v"(v)); return v; }
__device__ __forceinline__ size_t tiled_idx(int row, int col, int KT) { return ((size_t)(row >> 8) * KT + (col >> 6)) * 16384 + (size_t)((row & 255) * 64 + (col & 63)); }
#define XB_TMO      128
#define XB_XCNT(j)  (256  + 64 * (j))
#define XB_XSUB(j)  (1280 + 64 * (j))
#define XB_XGEN(j)  (2304 + 64 * (j))
#define XB_TOP      3328
#define XB_TOPGEN   3392
#define XCD_BAR_WORDS 3456
#define XB_SPIN_CAP (1u << 18)

__device__ __forceinline__ unsigned xb_ld(unsigned* p)              { return __hip_atomic_load(p, __ATOMIC_RELAXED, __HIP_MEMORY_SCOPE_AGENT); }
__device__ __forceinline__ unsigned xb_add(unsigned* p, unsigned v) { return __hip_atomic_fetch_add(p, v, __ATOMIC_RELAXED, __HIP_MEMORY_SCOPE_AGENT); }
__device__ __forceinline__ unsigned xb_xcc_id() { return (unsigned)__builtin_amdgcn_s_getreg((3 << 11) | 20) & 0xFu; }
#define XB_SPIN(cond, bar) do { unsigned _sp = 0; while (cond) { __builtin_amdgcn_s_sleep(1); \
    if ((++_sp & 255u) == 0u) { if (xb_ld(&(bar)[XB_TMO])) break; if (_sp > XB_SPIN_CAP) { atomicAdd(&(bar)[XB_TMO], 1u); break; } } } } while (0)

struct XcdBarrier {
    unsigned* bar; unsigned x;
    volatile LAS unsigned* st;
};

__device__ __forceinline__ XcdBarrier xcd_barrier_post(unsigned* bar, volatile LAS unsigned* st) {
    XcdBarrier b; b.bar = bar; b.x = xb_xcc_id(); b.st = st;
    if (threadIdx.x == 0) (void)xb_add(&bar[XB_XCNT(b.x)], 1u);
    return b;
}
__device__ __forceinline__ void xcd_barrier_complete(unsigned* bar, unsigned x, unsigned& nloc, unsigned& nx) {
    const unsigned G = gridDim.x * gridDim.y * gridDim.z;
    unsigned sum, cnt, mine, sp = 0u;
    for (;;) {
        sum = 0u; cnt = 0u; mine = 0u;
#pragma unroll
        for (unsigned j = 0; j < 16; ++j) { const unsigned c = xb_ld(&bar[XB_XCNT(j)]); sum += c; cnt += (c > 0u) ? 1u : 0u; mine = (j == x) ? c : mine; }
        if (sum == G) break;
        __builtin_amdgcn_s_sleep(1);
        if ((++sp & 255u) == 0u) { if (xb_ld(&bar[XB_TMO])) break; if (sp > XB_SPIN_CAP) { atomicAdd(&bar[XB_TMO], 1u); break; } }
    }
    nloc = mine > 0u ? mine : 1u; nx = cnt > 0u ? cnt : 1u;
}

__device__ __forceinline__ void xcd_barrier(const XcdBarrier& b) {
    asm volatile("s_waitcnt vmcnt(0)" ::: "memory");
    __syncthreads();
    if (threadIdx.x == 0) {
        unsigned* bar = b.bar;
        __builtin_amdgcn_s_waitcnt(0);
        unsigned nloc = b.st[0], nx = b.st[1];
        if (nloc == 0u) { xcd_barrier_complete(bar, b.x, nloc, nx); b.st[0] = nloc; b.st[1] = nx; }
        const unsigned old = xb_add(&bar[XB_XSUB(b.x)], 1u);
        const unsigned gen = old / nloc;
        if (old + 1u == (gen + 1u) * nloc) {
            __builtin_amdgcn_fence(__ATOMIC_RELEASE, "agent");
            asm volatile("s_waitcnt vmcnt(0)" ::: "memory");
            const unsigned og = xb_add(&bar[XB_TOP], 1u);
            const unsigned tg = og / nx;
            if (og + 1u == (tg + 1u) * nx) xb_add(&bar[XB_TOPGEN], 1u);
            else XB_SPIN(xb_ld(&bar[XB_TOPGEN]) == tg, bar);
            __builtin_amdgcn_fence(__ATOMIC_ACQUIRE, "agent");
            xb_add(&bar[XB_XGEN(b.x)], 1u);
            asm volatile("s_waitcnt vmcnt(0)" ::: "memory");
        } else {
            XB_SPIN(xb_ld(&bar[XB_XGEN(b.x)]) == gen, bar);
            __builtin_amdgcn_fence(__ATOMIC_ACQUIRE, "agent");
            asm volatile("s_waitcnt vmcnt(0)" ::: "memory");
        }
    }
    __syncthreads();
}

struct TItem { const float* src; const float* kscale; bf16* dst; int N; int nt; };
__device__ __forceinline__ unsigned cvtpk_rne(float lo, float hi) { unsigned r; asm volatile("v_cvt_pk_bf16_f32 %0, %1, %2" : "=v"(r) : "v"(lo), "v"(hi)); return r; }
__device__ __forceinline__ void titem_load(const TItem& t, int lane, f32x4 (&v)[8]) {
    const float* p = t.src + (size_t)(8 * (lane >> 3)) * t.N + 4 * (lane & 7);
#pragma unroll
    for (int j = 0; j < 8; ++j) v[j] = __builtin_nontemporal_load((const f32x4*)(p + (size_t)j * t.N));
}
__device__ __forceinline__ void titem_store(const TItem& t, int lane, f32x4 (&v)[8]) {
    const int kg = lane >> 3, n4 = lane & 7;
    if (t.kscale) { const f32x4 s0 = *(const f32x4*)(t.kscale + 8 * kg), s1 = *(const f32x4*)(t.kscale + 8 * kg + 4);
        v[0] *= s0[0]; v[1] *= s0[1]; v[2] *= s0[2]; v[3] *= s0[3]; v[4] *= s1[0]; v[5] *= s1[1]; v[6] *= s1[2]; v[7] *= s1[3]; }
    bf16* d = t.dst + (4 * n4) * 64 + 8 * kg;
#pragma unroll
    for (int i = 0; i < 4; ++i) { v4u o; o.x = cvtpk_rne(v[0][i], v[1][i]); o.y = cvtpk_rne(v[2][i], v[3][i]); o.z = cvtpk_rne(v[4][i], v[5][i]); o.w = cvtpk_rne(v[6][i], v[7][i]);
        if (t.nt) __builtin_nontemporal_store(o, (v4u*)(d + i * 64)); else *(GAS v4u*)(d + i * 64) = o; }
}
__device__ __forceinline__ TItem titem_make(const float* W, int K, int N, bf16* WT, int dst_row0, int k0, int n0, const float* kscale, int nt = 0) {
    TItem t; t.src = W + (size_t)k0 * N + n0; t.kscale = kscale; t.N = N; t.nt = nt;
    t.dst = WT + ((size_t)(dst_row0 >> 8) * (K >> 6) + (k0 >> 6)) * (256 * 64) + (dst_row0 & 255) * 64; return t;
}
__device__ __forceinline__ int gu_row(int n0, int up) { return 256 * (n0 >> 7) + (n0 & 127) + (up ? 128 : 0); }
__device__ __forceinline__ int in_row(int n0) {
    if (n0 >= ZV) return n0;
    const int rb = n0 < ZK ? 0 : ZK, c = n0 - rb, head = c >> 7, d0 = c & 127, axis = d0 >> 6, x2 = (d0 >> 5) & 1;
    return rb + (head >> 1) * 256 + x2 * 128 + (head & 1) * 64 + axis * 32;
}

struct P0Args { const float *c, *cache_k, *cache_v, *c_ctx, *w_mod, *b_mod, *w_in, *g_attn, *g_conv, *w_o, *wg1, *wu1, *wd1, *wg2, *wu2, *wd2;
                float *MOD, *ROPE; bf16 *CK, *CV, *WGU1, *WD1, *WIN, *WO, *WGU2, *WD2; unsigned char* ws; };
constexpr int I_GU = (DM / 64) * (DFF / 32), I_D = (DFF / 64) * (DM / 32), I_IN = (DM / 64) * (INW / 32), I_O = (DM / 64) * (DM / 32);
constexpr int CI_P0_END = 2 * I_GU + I_IN + I_O, CI_WD1_END = CI_P0_END + I_D, CI_GU2_END = CI_WD1_END + 2 * I_GU, CI_END = CI_GU2_END + I_D;
constexpr int CI_X1 = CI_WD1_END + 30208, CI_X2 = CI_GU2_END + 4928;
static_assert(CI_X1 < CI_GU2_END && CI_X2 < CI_END, "split points");
__device__ __forceinline__ TItem titem_decode(const P0Args& A, int it) {
    int r = it;
    if (r < I_GU) { const int kb = r / (DFF / 32), nb = r % (DFF / 32); return titem_make(A.wg1, DM, DFF, A.WGU1, gu_row(32 * nb, 0), 64 * kb, 32 * nb, nullptr); } r -= I_GU;
    if (r < I_GU) { const int kb = r / (DFF / 32), nb = r % (DFF / 32); return titem_make(A.wu1, DM, DFF, A.WGU1, gu_row(32 * nb, 1), 64 * kb, 32 * nb, nullptr); } r -= I_GU;
    if (r < I_IN) { const int kb = r / (INW / 32), nb = r % (INW / 32); return titem_make(A.w_in, DM, INW, A.WIN, in_row(32 * nb), 64 * kb, 32 * nb, nullptr, 1); } r -= I_IN;
    if (r < I_O) { const int kb = r / (DM / 32), nb = r % (DM / 32); const int k0 = 64 * kb; return titem_make(A.w_o, DM, DM, A.WO, 32 * nb, k0, 32 * nb, k0 < 2048 ? A.g_attn + k0 : A.g_conv + (k0 - 2048), 1); } r -= I_O;
    if (r < I_D) { const int kb = r / (DM / 32), nb = r % (DM / 32); return titem_make(A.wd1, DFF, DM, A.WD1, 32 * nb, 64 * kb, 32 * nb, nullptr); } r -= I_D;
    if (r < I_GU) { const int kb = r / (DFF / 32), nb = r % (DFF / 32); return titem_make(A.wg2, DM, DFF, A.WGU2, gu_row(32 * nb, 0), 64 * kb, 32 * nb, nullptr, 1); } r -= I_GU;
    if (r < I_GU) { const int kb = r / (DFF / 32), nb = r % (DFF / 32); return titem_make(A.wu2, DM, DFF, A.WGU2, gu_row(32 * nb, 1), 64 * kb, 32 * nb, nullptr, 1); } r -= I_GU;
    { const int kb = r / (DM / 32), nb = r % (DM / 32); return titem_make(A.wd2, DFF, DM, A.WD2, 32 * nb, 64 * kb, 32 * nb, nullptr); }
}
__device__ __forceinline__ void convert_items(LAS unsigned char* lds, const P0Args& A, int wave, int lane, int it_begin, int it_end, int worker, int n_workers) {
    int it = it_begin + worker; if (it >= it_end) return;
    TItem ta = titem_decode(A, it), tb = ta; f32x4 va[8], vb[8]; titem_load(ta, lane, va);
    for (;;) {
        int nit = it + n_workers; bool more = nit < it_end;
        if (more) { tb = titem_decode(A, nit); titem_load(tb, lane, vb); }
        titem_store(ta, lane, va);
        if (!more) break;
        it = nit; nit = it + n_workers; more = nit < it_end;
        if (more) { ta = titem_decode(A, nit); titem_load(ta, lane, va); }
        titem_store(tb, lane, vb);
        if (!more) break;
        it = nit; }
}
__device__ __forceinline__ void convert_items_dyn(const P0Args& A, int lane, int it_begin, int it_end, gu32* ctr) {
    unsigned raw = 0u;
    if (lane == 0) raw = __hip_atomic_fetch_add(ctr, 2u, RLX_AGENT);
    int ia = it_begin + (int)__builtin_amdgcn_readfirstlane(raw); if (ia >= it_end) return;
    TItem ta = titem_decode(A, ia), tb = ta; f32x4 va[8], vb[8]; titem_load(ta, lane, va);
    for (;;) {
        const int ib = ia + 1;
        raw = 0u; if (lane == 0) raw = __hip_atomic_fetch_add(ctr, 2u, RLX_AGENT);
        asm volatile("" ::: "memory");
        if (ib < it_end) { tb = titem_decode(A, ib); titem_load(tb, lane, vb); }
        titem_store(ta, lane, va);
        if (ib >= it_end) break;
        const int nx = it_begin + (int)__builtin_amdgcn_readfirstlane(raw);
        if (nx < it_end) { ta = titem_decode(A, nx); titem_load(ta, lane, va); }
        titem_store(tb, lane, vb);
        if (nx >= it_end) break;
        ia = nx; }
}
__device__ __forceinline__ void tail_convert(LAS unsigned char* lds, const P0Args& A, int wave, int lane, int G, int nunits, int it_begin, int it_end) {
    const int first = nunits % G;
    if ((int)blockIdx.x >= first) convert_items(lds, A, wave, lane, it_begin, it_end, ((int)blockIdx.x - first) * NWAVES + wave, (G - first) * NWAVES);
}
__device__ __forceinline__ void phase0(LAS unsigned char* lds, const P0Args& A, int tid, int wave, int lane, int G) {
    LAS float* SC = (LAS float*)(lds + 67584);
    LAS float* RED = (LAS float*)(lds + 116736);
    for (int i = tid; i < 3 * DM; i += NWAVES * 64) { const int c = i >> 12, k = i & 4095; const float x = c == 0 ? A.c_ctx[k] : A.c[(c - 1) * DM + k]; SC[i] = x / (1.0f + __expf(-x)); }
    __syncthreads();
    for (int ch = blockIdx.x; ch < 256; ch += G) {
        f32x4 a0 = {0.f, 0.f, 0.f, 0.f}, a1 = a0, a2 = a0;
        if (lane < 36) { const float* wp = A.w_mod + (size_t)(512 * wave) * MODW + 144 * ch + 4 * lane; const LAS float* sc = SC + 512 * wave;
            for (int k = 0; k < 512; k += 16) { f32x4 w[16];
#pragma unroll
                for (int u = 0; u < 16; ++u) w[u] = __builtin_nontemporal_load((const f32x4*)(wp + (size_t)(k + u) * MODW));
#pragma unroll
                for (int u = 0; u < 16; ++u) { a0 += sc[k + u] * w[u]; a1 += sc[DM + k + u] * w[u]; a2 += sc[2 * DM + k + u] * w[u]; } }
            *(LAS f32x4*)(RED + (wave * 3 + 0) * 144 + 4 * lane) = a0; *(LAS f32x4*)(RED + (wave * 3 + 1) * 144 + 4 * lane) = a1; *(LAS f32x4*)(RED + (wave * 3 + 2) * 144 + 4 * lane) = a2; }
        __syncthreads();
        if (tid < 432) { const int c = tid / 144, j = tid % 144; float s = 0.f;
#pragma unroll
            for (int w = 0; w < 8; ++w) s += RED[(w * 3 + c) * 144 + j];
            A.MOD[(size_t)c * MODW + 144 * ch + j] = s + A.b_mod[144 * ch + j]; }
        __syncthreads();
    }
    const int gtid = blockIdx.x * (NWAVES * 64) + tid, gthreads = G * NWAVES * 64;
    for (int i = gtid; i < 2048; i += gthreads) { const int pos = i >> 5, fi = i & 31; const float f = powf(10000.0f, -(float)fi / 32.0f); const float a = (float)pos * f; A.ROPE[2 * i] = cosf(a); A.ROPE[2 * i + 1] = sinf(a); }
    for (int i = gtid; i < 65536; i += gthreads) { const int which = i >> 15, j = i & 32767; const float* src = (which ? A.cache_v : A.cache_k) + (size_t)j * 8;
        const f32x4 x0 = *(const f32x4*)src, x1 = *(const f32x4*)(src + 4); v4u o; o.x = pk2(x0[0], x0[1]); o.y = pk2(x0[2], x0[3]); o.z = pk2(x1[0], x1[1]); o.w = pk2(x1[2], x1[3]);
        *(v4u*)((which ? A.CV : A.CK) + (size_t)j * 8) = o; }
    { const int part = blockIdx.x & 7, per = CI_P0_END / 8;
      convert_items_dyn(A, lane, part * per, part == 7 ? CI_P0_END : (part + 1) * per, (gu32*)(A.ws + WS_CTL) + 2048 + 64 * part); }
}

struct RowF { f32x4 a[8], b[8]; };
__device__ __forceinline__ void row_load_f32(RowF& r, const float* p, int lane) {
    const f32x4* q = (const f32x4*)p + 2 * lane;
#pragma unroll
    for (int j = 0; j < 8; ++j) { r.a[j] = __builtin_nontemporal_load(q + 128 * j); r.b[j] = __builtin_nontemporal_load(q + 128 * j + 1); }
}
__device__ __forceinline__ float ssq4(const f32x4 v) { return (v[0] * v[0] + v[1] * v[1]) + (v[2] * v[2] + v[3] * v[3]); }
constexpr int RV_PV = 0, RV_PA = 16384, RV_PS = 32768;
__device__ __forceinline__ f32x4 rv_ld(const LAS unsigned char* v, int j, int h, int lane) { return *(const LAS f32x4*)(v + ((2 * j + h) * 64 + lane) * 16); }
__device__ __forceinline__ void rv_st(LAS unsigned char* v, int tid, f32x4 x0, f32x4 x1) {
    const int j = tid >> 6, l = tid & 63; *(LAS f32x4*)(v + ((2 * j) * 64 + l) * 16) = x0; *(LAS f32x4*)(v + ((2 * j + 1) * 64 + l) * 16) = x1;
}
__device__ __forceinline__ void rows_fill_post(LAS unsigned char* lds, const float* gate, const float* gpost, int tid) {
    const f32x4 ga0 = ((const f32x4*)gate)[2 * tid], ga1 = ((const f32x4*)gate)[2 * tid + 1], gp0 = ((const f32x4*)gpost)[2 * tid], gp1 = ((const f32x4*)gpost)[2 * tid + 1];
    rv_st(lds + RV_PV, tid, ga0 * gp0, ga1 * gp1);
}
__device__ __forceinline__ void rows_fill_pre(LAS unsigned char* lds, const float* gpre, const float* shift, const float* scale, int tid) {
    const f32x4 g0 = ((const f32x4*)gpre)[2 * tid], g1 = ((const f32x4*)gpre)[2 * tid + 1], c0 = ((const f32x4*)scale)[2 * tid], c1 = ((const f32x4*)scale)[2 * tid + 1];
    rv_st(lds + RV_PA, tid, g0 * (1.0f + c0), g1 * (1.0f + c1));
    rv_st(lds + RV_PS, tid, ((const f32x4*)shift)[2 * tid], ((const f32x4*)shift)[2 * tid + 1]);
}
__device__ __forceinline__ void row_emit_u(const RowF& h, float r, const LAS unsigned char* lds, bf16* U, int row, int lane) {
#pragma unroll
    for (int jj = 0; jj < 8; jj += 2) {
#pragma unroll
        for (int j = jj; j < jj + 2; ++j) {
            const f32x4 a0 = rv_ld(lds + RV_PA, j, 0, lane), a1 = rv_ld(lds + RV_PA, j, 1, lane), s0 = rv_ld(lds + RV_PS, j, 0, lane), s1 = rv_ld(lds + RV_PS, j, 1, lane);
            const f32x4 y0 = (h.a[j] * r) * a0 + s0, y1 = (h.b[j] * r) * a1 + s1;
            v4u w; w.x = cvtpk_rne(y0[0], y0[1]); w.y = cvtpk_rne(y0[2], y0[3]); w.z = cvtpk_rne(y1[0], y1[1]); w.w = cvtpk_rne(y1[2], y1[3]); *(v4u*)(U + tiled_idx(row, 8 * lane + 512 * j, DM / 64)) = w; }
        asm volatile("" ::: "memory"); }
}
#define ROW_SRC(row) ((row) < NCTX ? x_prompt + (size_t)(row) * DM : x_sample + (size_t)((row) - NCTX) * DM)
#define RB_MOD(rb, s, j) (MOD + (size_t)((rb) < NCTX / 32 ? 0 : 1 + (((rb) - NCTX / 32) >> 6)) * MODW + ((s) * 3 + (j)) * DM)
__device__ __forceinline__ void rows_pre(LAS unsigned char* lds, const float* x_prompt, const float* x_sample, const float* MOD, const float* gpre, bf16* U, int tid, int wave, int lane0, int G) {
    for (int rb = blockIdx.x; rb < NTOK / 32; rb += G) { const int row0 = 32 * rb + wave;
        RowF nx; row_load_f32(nx, ROW_SRC(row0), lane0);
        rows_fill_pre(lds, gpre, RB_MOD(rb, 0, 0), RB_MOD(rb, 0, 1), tid);
        __syncthreads();
        for (int i = 0; i < 4; ++i) { const int row = row0 + 8 * i, lane = opaque(lane0);
            RowF h = nx; if (i < 3) row_load_f32(nx, ROW_SRC(row + 8), lane);
            float s = 0.f;
#pragma unroll
            for (int j = 0; j < 8; ++j) s += ssq4(h.a[j]) + ssq4(h.b[j]);
            const float r = 1.0f / sqrtf(wave_sum(s) * (1.0f / DM) + EPS);
            row_emit_u(h, r, lds, U, row, lane); }
        __syncthreads(); }
}
__device__ __forceinline__ void row_from_bf16(RowF& r, const v4u (&w)[8]) {
#pragma unroll
    for (int j = 0; j < 8; ++j) { r.a[j] = (f32x4){bflo(w[j].x), bfhi(w[j].x), bflo(w[j].y), bfhi(w[j].y)}; r.b[j] = (f32x4){bflo(w[j].z), bfhi(w[j].z), bflo(w[j].w), bfhi(w[j].w)}; }
}
template <bool NEXT, bool SRC_X, int S>
__device__ __forceinline__ void rows_post_pre(LAS unsigned char* lds, const float* x_prompt, const float* x_sample, bf16* Hb, const bf16* O, const float* MOD, float resw, const float* gpost, float* Yout,
                                              const float* gpre, bf16* U, int tid, int wave, int lane0, int G) {
    for (int rb = blockIdx.x; rb < NTOK / 32; rb += G) { const int row0 = 32 * rb + wave;
        RowF nh; v4u nhb[8], no[8];
        if constexpr (SRC_X) row_load_f32(nh, ROW_SRC(row0), lane0);
        else {
#pragma unroll
            for (int j = 0; j < 8; ++j) nhb[j] = __builtin_nontemporal_load(((const v4u*)(Hb + (size_t)row0 * DM)) + lane0 + 64 * j); }
#pragma unroll
        for (int j = 0; j < 8; ++j) no[j] = __builtin_nontemporal_load(((const v4u*)(O + (size_t)row0 * DM)) + lane0 + 64 * j);
        rows_fill_post(lds, RB_MOD(rb, S, 2), gpost, tid);
        if constexpr (NEXT) rows_fill_pre(lds, gpre, RB_MOD(rb, S + 1, 0), RB_MOD(rb, S + 1, 1), tid);
        __syncthreads();
        for (int i = 0; i < 4; ++i) { const int row = row0 + 8 * i, lane = opaque(lane0);
            RowF h; if constexpr (SRC_X) h = nh; else row_from_bf16(h, nhb);
            v4u o[8];
#pragma unroll
            for (int j = 0; j < 8; ++j) o[j] = no[j];
            const int nrow = row + 8;
            if (i < 3) {
#pragma unroll
                for (int j = 0; j < 8; ++j) no[j] = __builtin_nontemporal_load(((const v4u*)(O + (size_t)nrow * DM)) + lane + 64 * j);
                if constexpr (!SRC_X) {
#pragma unroll
                    for (int j = 0; j < 8; ++j) nhb[j] = __builtin_nontemporal_load(((const v4u*)(Hb + (size_t)nrow * DM)) + lane + 64 * j); } }
            float s = 0.f;
#pragma unroll
            for (int j = 0; j < 8; ++j) { const float a0 = bflo(o[j].x), a1 = bfhi(o[j].x), a2 = bflo(o[j].y), a3 = bfhi(o[j].y), a4 = bflo(o[j].z), a5 = bfhi(o[j].z), a6 = bflo(o[j].w), a7 = bfhi(o[j].w);
                s += ((a0 * a0 + a1 * a1) + (a2 * a2 + a3 * a3)) + ((a4 * a4 + a5 * a5) + (a6 * a6 + a7 * a7)); }
            const float ro = resw / sqrtf(wave_sum(s) * (1.0f / DM) + EPS);
            s = 0.f;
#pragma unroll
            for (int jj = 0; jj < 8; jj += 2) {
#pragma unroll
                for (int j = jj; j < jj + 2; ++j) {
                    const f32x4 pv0 = rv_ld(lds + RV_PV, j, 0, lane), pv1 = rv_ld(lds + RV_PV, j, 1, lane);
                    const f32x4 o0 = {bflo(o[j].x), bfhi(o[j].x), bflo(o[j].y), bfhi(o[j].y)}, o1 = {bflo(o[j].z), bfhi(o[j].z), bflo(o[j].w), bfhi(o[j].w)};
                    h.a[j] = h.a[j] + (ro * pv0) * o0; h.b[j] = h.b[j] + (ro * pv1) * o1; s += ssq4(h.a[j]) + ssq4(h.b[j]);
                    if constexpr (NEXT) { v4u w; w.x = cvtpk_rne(h.a[j][0], h.a[j][1]); w.y = cvtpk_rne(h.a[j][2], h.a[j][3]); w.z = cvtpk_rne(h.b[j][0], h.b[j][1]); w.w = cvtpk_rne(h.b[j][2], h.b[j][3]);
                        __builtin_nontemporal_store(w, ((v4u*)(Hb + (size_t)row * DM)) + lane + 64 * j); }
                    else { f32x4* yo = (f32x4*)(Yout + (size_t)row * DM) + 2 * lane; __builtin_nontemporal_store(h.a[j], yo + 128 * j); __builtin_nontemporal_store(h.b[j], yo + 128 * j + 1); } }
                asm volatile("" ::: "memory"); }
            if constexpr (SRC_X) { if (i < 3) row_load_f32(nh, ROW_SRC(nrow), lane); }
            if constexpr (NEXT) { const float r = 1.0f / sqrtf(wave_sum(s) * (1.0f / DM) + EPS);
                row_emit_u(h, r, lds, U, row, lane); } }
        __syncthreads(); }
}
#undef ROW_SRC
#undef RB_MOD

namespace att {
constexpr float SCALE = 0.088388347648318440f;
#define KSWZ(row, colB) ((row) * 256 + ((colB) ^ (((row) & 7) << 4)))
#define SBAR() __builtin_amdgcn_sched_barrier(0)
__device__ __forceinline__ int crow(int r, int hi) { return (r & 3) + 8 * (r >> 2) + 4 * hi; }
__device__ __forceinline__ unsigned cvtpk(float lo, float hi) { unsigned r; asm volatile("v_cvt_pk_bf16_f32 %0, %1, %2" : "=v"(r) : "v"(lo), "v"(hi)); return r; }
__device__ __forceinline__ void partialSM(f32x16& p0, f32x16& p1, float& m_reg, float& alpha) {
    constexpr float C = SCALE * 1.4426950408889634f;
    float pmax = p0[0];
#pragma unroll
    for (int r = 1; r < 16; ++r) pmax = fmaxf(pmax, p0[r]);
#pragma unroll
    for (int r = 0; r < 16; ++r) pmax = fmaxf(pmax, p1[r]);
    { auto rr = __builtin_amdgcn_permlane32_swap(__float_as_uint(pmax), __float_as_uint(pmax), false, false); pmax = fmaxf(__uint_as_float(rr[0]), __uint_as_float(rr[1])); }
    float mn;
    if (__all(pmax <= m_reg)) { mn = m_reg; alpha = 1.f; }
    else { mn = fmaxf(m_reg, pmax); alpha = __builtin_amdgcn_exp2f((m_reg - mn) * C); m_reg = mn; }
    const float mnC = -mn * C;
#pragma unroll
    for (int r = 0; r < 16; ++r) { p0[r] = __builtin_amdgcn_exp2f(fmaf(p0[r], C, mnC)); p1[r] = __builtin_amdgcn_exp2f(fmaf(p1[r], C, mnC)); }
}
__device__ __forceinline__ void finishSM(const f32x16& p0, const f32x16& p1, float alpha, float& l_reg, bf16x8& pa0, bf16x8& pa1, bf16x8& pa2, bf16x8& pa3) {
    float ps = 0;
#pragma unroll
    for (int r = 0; r < 16; ++r) ps += p0[r];
#pragma unroll
    for (int r = 0; r < 16; ++r) ps += p1[r];
    { auto rr = __builtin_amdgcn_permlane32_swap(__float_as_uint(ps), __float_as_uint(ps), false, false); ps = __uint_as_float(rr[0]) + __uint_as_float(rr[1]); }
    l_reg = l_reg * alpha + ps;
#define PK4(P, BASE, OUT) do { unsigned a0 = cvtpk(P[BASE + 0], P[BASE + 1]), a1 = cvtpk(P[BASE + 2], P[BASE + 3]);   \
    unsigned b0 = cvtpk(P[BASE + 4], P[BASE + 5]), b1 = cvtpk(P[BASE + 6], P[BASE + 7]);                              \
    auto r0 = __builtin_amdgcn_permlane32_swap(a0, b0, false, false); auto r1 = __builtin_amdgcn_permlane32_swap(a1, b1, false, false); \
    v4u w = {r0[0], r1[0], r0[1], r1[1]}; OUT = __builtin_bit_cast(bf16x8, w); } while (0)
    PK4(p0, 0, pa0); PK4(p0, 8, pa1); PK4(p1, 0, pa2); PK4(p1, 8, pa3);
#undef PK4
}
__device__ __forceinline__ void qkt(f32x16& p0, f32x16& p1, const LAS unsigned char* Ks, const bf16x8* qr, int r32, int hi) {
    p0 = f32x16{}; p1 = f32x16{};
#pragma unroll
    for (int d0 = 0; d0 < 8; ++d0) { const int cb = (d0 * 16 + hi * 8) * 2;
        const bf16x8 b0 = *(const LAS bf16x8*)(Ks + KSWZ(r32, cb));
        const bf16x8 b1 = *(const LAS bf16x8*)(Ks + KSWZ(32 + r32, cb));
        p0 = __builtin_amdgcn_mfma_f32_32x32x16_bf16(b0, qr[d0], p0, 0, 0, 0);
        p1 = __builtin_amdgcn_mfma_f32_32x32x16_bf16(b1, qr[d0], p1, 0, 0, 0); }
}
__device__ __forceinline__ int v_st(int k, int c) { const int kk = (k & ~0xC) | ((k & 4) << 1) | ((k & 8) >> 1); return ((kk >> 3) * 4 + (c >> 5)) * 512 + ((kk & 7) * 32 + (c & 31)) * 2; }
__device__ __forceinline__ int v_rd_base(int lane) { return ((lane & 3) << 3) | (((lane >> 2) & 3) << 6) | (((lane >> 4) & 1) << 5) | (((lane >> 5) & 1) << 8); }
constexpr int v_rd_off(int d0, int ks, int half) { return d0 * 512 + ks * 4096 + half * 2048; }
template <int OFF> __device__ __forceinline__ s16x4 tr_read(int vb) { s16x4 r; asm volatile("ds_read_b64_tr_b16 %0, %1 offset:%2" : "=&v"(r) : "v"(vb), "i"(OFF) : "memory"); return r; }
template <int D0> __device__ __forceinline__ void pv_one(f32x16& od, int vb, bf16x8 pa0, bf16x8 pa1, bf16x8 pa2, bf16x8 pa3) {
    const s16x4 l0 = tr_read<v_rd_off(D0, 0, 0)>(vb), h0 = tr_read<v_rd_off(D0, 0, 1)>(vb), l1 = tr_read<v_rd_off(D0, 1, 0)>(vb), h1 = tr_read<v_rd_off(D0, 1, 1)>(vb);
    const s16x4 l2 = tr_read<v_rd_off(D0, 2, 0)>(vb), h2 = tr_read<v_rd_off(D0, 2, 1)>(vb), l3 = tr_read<v_rd_off(D0, 3, 0)>(vb), h3 = tr_read<v_rd_off(D0, 3, 1)>(vb);
    asm volatile("s_waitcnt lgkmcnt(0)" ::: "memory"); SBAR();
#define PK(L, H) (bf16x8){L[0], L[1], L[2], L[3], H[0], H[1], H[2], H[3]}
    od = __builtin_amdgcn_mfma_f32_32x32x16_bf16(pa0, PK(l0, h0), od, 0, 0, 0);
    od = __builtin_amdgcn_mfma_f32_32x32x16_bf16(pa1, PK(l1, h1), od, 0, 0, 0);
    od = __builtin_amdgcn_mfma_f32_32x32x16_bf16(pa2, PK(l2, h2), od, 0, 0, 0);
    od = __builtin_amdgcn_mfma_f32_32x32x16_bf16(pa3, PK(l3, h3), od, 0, 0, 0);
#undef PK
}
__device__ __forceinline__ void pv_d0(f32x16* o, int vb, bf16x8 pa0, bf16x8 pa1, bf16x8 pa2, bf16x8 pa3) {
    pv_one<0>(o[0], vb, pa0, pa1, pa2, pa3); pv_one<1>(o[1], vb, pa0, pa1, pa2, pa3); pv_one<2>(o[2], vb, pa0, pa1, pa2, pa3); pv_one<3>(o[3], vb, pa0, pa1, pa2, pa3);
}
__device__ __forceinline__ void loadU8(const bf16* Z, int rowbase, int t, int L, int ch, float (&u)[8]) {
    const int tc = t < 0 ? 0 : (t >= L ? L - 1 : t); const float f = (t < 0 || t >= L) ? 0.f : 1.f;
    const bf16* zr = Z + (size_t)(rowbase + tc) * INW + ch; const v4u c8 = *(const v4u*)(zr + ZC), h8 = *(const v4u*)(zr + ZH);
    u[0] = bflo(c8.x) * bflo(h8.x) * f; u[1] = bfhi(c8.x) * bfhi(h8.x) * f; u[2] = bflo(c8.y) * bflo(h8.y) * f; u[3] = bfhi(c8.y) * bfhi(h8.y) * f;
    u[4] = bflo(c8.z) * bflo(h8.z) * f; u[5] = bfhi(c8.z) * bfhi(h8.z) * f; u[6] = bflo(c8.w) * bflo(h8.w) * f; u[7] = bfhi(c8.w) * bfhi(h8.w) * f;
}
__device__ __forceinline__ void attn_conv_unit(LAS unsigned char* lds, int unit, const bf16* Z, const bf16* CK, const bf16* CV, const float* sink, const float* wconv, bf16* MRG, int tid, int wid, int lane) {
    const bool lat = unit >= 128; const int v = lat ? unit - 128 : unit;
    const int seq = lat ? (v >> 6) : (v >> 3), blk = lat ? (v & 63) : (v & 7);
    const int rowbase = lat ? NCTX + seq * LAT_T : seq * CTX_T, t0 = blk * 32, L = lat ? LAT_T : CTX_T;
    const int r32 = lane & 31, hi = lane >> 5, set = wid >> 2;
    int lo = 0, n_win = 4;
    if (lat) { lo = (t0 - 128) >> 6; if (lo < 0) lo = 0; int up = (t0 + 159) >> 6; if (up > 31) up = 31; n_win = up - lo + 1; }
    const int n_tiles = lat ? n_win + 4 : 4;
    const LAS unsigned char* Kset = lds + set * 32768;
    LAS float* li_l = (LAS float*)(lds + ATT_WS_OFF) + wid * 64; LAS float* al_l = li_l + 32;
    const int vb0 = (int)(unsigned)(uintptr_t)(lds + set * 32768 + 16384) + v_rd_base(lane);
    const int sset = tid >> 8, t8 = tid & 255, sr = t8 >> 4, sc = (t8 & 15) * 8;
    LAS unsigned char* sK = lds + sset * 32768; LAS unsigned char* sV = sK + 16384;
    bf16x8 qr[8], kx[4], vx[4];
#define ATT_TILE_LOAD_H(TI, SKVH) do { const bf16 *Kp_, *Vp_; int pitch_; \
            if (!lat || (TI) < n_win) { const int k0_ = 64 * (lo + (TI)); Kp_ = Z + (size_t)(rowbase + k0_) * INW + ZK + (SKVH) * 128; Vp_ = Kp_ + (ZV - ZK); pitch_ = INW; } \
            else { const int j_ = (TI) - n_win; Kp_ = CK + (size_t)(seq * 256 + 64 * j_) * 512 + (SKVH) * 128; Vp_ = CV + (size_t)(seq * 256 + 64 * j_) * 512 + (SKVH) * 128; pitch_ = 512; } \
            _Pragma("unroll") for (int i_ = 0; i_ < 4; ++i_) { kx[i_] = *(const bf16x8*)(Kp_ + (size_t)(sr + 16 * i_) * pitch_ + sc); vx[i_] = *(const bf16x8*)(Vp_ + (size_t)(sr + 16 * i_) * pitch_ + sc); } } while (0)
#define ATT_TILE_LOAD(TI) ATT_TILE_LOAD_H(TI, skvh)
#define ATT_PASS_REQ(PASS) ATT_TILE_LOAD_H(0, 2 * (PASS) + sset)
    ATT_PASS_REQ(0);
    for (int pass = 0; pass < 2; ++pass) {
        const int kvh = 2 * pass + set, qhead = 4 * kvh + (wid & 3), skvh = 2 * pass + sset;
        { const bf16* qp = Z + (size_t)(rowbase + t0 + r32) * INW + qhead * 128 + hi * 8;
#pragma unroll
          for (int d0 = 0; d0 < 8; ++d0) qr[d0] = *(const bf16x8*)(qp + d0 * 16); }
        float m_reg = sink[qhead] * (1.0f / SCALE), l_reg = 1.0f; f32x16 o[4] = {};
        for (int ti = 0; ti < n_tiles; ++ti) {
            const bool masked = lat && ti < n_win; const int key0 = 64 * (lo + ti);
            __syncthreads();
#pragma unroll
            for (int i = 0; i < 4; ++i) { const int row = sr + 16 * i; *(LAS bf16x8*)(sK + KSWZ(row, sc * 2)) = kx[i]; *(LAS bf16x8*)(sV + v_st(row, sc)) = vx[i]; }
            __syncthreads();
            if (ti + 1 < n_tiles) ATT_TILE_LOAD(ti + 1);
            f32x16 p0, p1; qkt(p0, p1, Kset, qr, r32, hi);
            if (masked && (key0 < t0 - 97 || key0 > t0 + 65)) {
                const int db = opaque(t0 + r32 - key0 - 4 * hi + 128);
#pragma unroll
                for (int r = 0; r < 16; ++r) { const int c = (r & 3) + 8 * (r >> 2); if ((unsigned)(db - c) > 256u) p0[r] = -1e30f; if ((unsigned)(db - c - 32) > 256u) p1[r] = -1e30f; } }
            float alpha; partialSM(p0, p1, m_reg, alpha);
            if (__any(alpha < 1.f)) { if (hi == 0) al_l[r32] = alpha; LDS_WAIT();
#pragma unroll
                for (int d = 0; d < 4; ++d)
#pragma unroll
                    for (int r = 0; r < 16; ++r) o[d][r] *= al_l[crow(r, hi)]; }
            bf16x8 pa0, pa1, pa2, pa3; finishSM(p0, p1, alpha, l_reg, pa0, pa1, pa2, pa3);
            pv_d0(o, vb0, pa0, pa1, pa2, pa3);
        }
        if (pass == 0) ATT_PASS_REQ(1);
        if (hi == 0) li_l[r32] = l_reg;
        LDS_WAIT();
        float rli[16];
#pragma unroll
        for (int r = 0; r < 16; ++r) rli[r] = 1.0f / li_l[crow(r, hi)];
        __syncthreads();
        LAS unsigned char* stg = lds + (pass == 0 ? ATT_STG : 0);
#pragma unroll
        for (int r = 0; r < 16; ++r)
#pragma unroll
            for (int d0 = 0; d0 < 4; ++d0) *(LAS unsigned short*)(stg + crow(r, hi) * 2064 + (wid * 128 + 32 * d0 + r32) * 2) = (unsigned short)f2bf(o[d0][r] * rli[r]);
    }
#undef ATT_PASS_REQ
#undef ATT_TILE_LOAD
#undef ATT_TILE_LOAD_H
    __syncthreads();
#pragma unroll
    for (int tk = 0; tk < 4; ++tk) { const int token = 4 * wid + tk; const size_t row = (size_t)(rowbase + t0 + token); lane = opaque(lane);
        v4u x[4]; x[0] = *(const LAS v4u*)(lds + ATT_STG + token * 2064 + lane * 16); x[1] = *(const LAS v4u*)(lds + ATT_STG + token * 2064 + (lane + 64) * 16);
        x[2] = *(const LAS v4u*)(lds + token * 2064 + lane * 16); x[3] = *(const LAS v4u*)(lds + token * 2064 + (lane + 64) * 16);
        float s = 0.f;
#pragma unroll
        for (int i = 0; i < 4; ++i) { const float a0 = bflo(x[i].x), a1 = bfhi(x[i].x), a2 = bflo(x[i].y), a3 = bfhi(x[i].y), a4 = bflo(x[i].z), a5 = bfhi(x[i].z), a6 = bflo(x[i].w), a7 = bfhi(x[i].w);
            s += (a0 * a0 + a1 * a1) + (a2 * a2 + a3 * a3) + (a4 * a4 + a5 * a5) + (a6 * a6 + a7 * a7); }
        const float rs = 1.0f / sqrtf(wave_sum(s) * (1.0f / 2048.0f) + EPS);
#pragma unroll
        for (int i = 0; i < 4; ++i) { v4u w; w.x = pk2(bflo(x[i].x) * rs, bfhi(x[i].x) * rs); w.y = pk2(bflo(x[i].y) * rs, bfhi(x[i].y) * rs); w.z = pk2(bflo(x[i].z) * rs, bfhi(x[i].z) * rs); w.w = pk2(bflo(x[i].w) * rs, bfhi(x[i].w) * rs);
            *(v4u*)(MRG + tiled_idx((int)row, (i >> 1) * 1024 + (lane + 64 * (i & 1)) * 8, DM / 64)) = w; } }
    asm volatile("" ::: "memory");
    { LAS float* CSSQ = (LAS float*)(lds + ATT_WS_OFF);
      LAS float* CRS = CSSQ + 256;
      const int ch = 256 * wid + 4 * opaque(lane);
      const f32x4 w0 = *(const f32x4*)(wconv + ch), w1 = *(const f32x4*)(wconv + 2048 + ch), w2 = *(const f32x4*)(wconv + 4096 + ch);
      unsigned cpk[32][2];
      v2u c4[2][10], h4[2][10], g4[2][8];
#define CONV_LOAD(BT, SET) do { const int tb_ = t0 + 8 * (BT); \
          _Pragma("unroll") for (int r = 0; r < 10; ++r) { const int t = tb_ - 1 + r, tc = t < 0 ? 0 : (t >= L ? L - 1 : t); const bf16* zr = Z + (size_t)(rowbase + tc) * INW + ch; \
              c4[SET][r] = *(const v2u*)(zr + ZC); h4[SET][r] = *(const v2u*)(zr + ZH); } \
          _Pragma("unroll") for (int i = 0; i < 8; ++i) g4[SET][i] = *(const v2u*)(Z + (size_t)(rowbase + tb_ + i) * INW + ZB + ch); } while (0)
      CONV_LOAD(0, 0);
#pragma unroll
      for (int bt = 0; bt < 4; ++bt) { const int tb = t0 + 8 * bt, cs = bt & 1;
          if (bt < 3) CONV_LOAD(bt + 1, cs ^ 1);
          f32x4 u[10];
#pragma unroll
          for (int r = 0; r < 10; ++r) { const int t = tb - 1 + r; const float f = (t < 0 || t >= L) ? 0.f : 1.f;
              u[r] = (f32x4){bflo(c4[cs][r].x) * bflo(h4[cs][r].x), bfhi(c4[cs][r].x) * bfhi(h4[cs][r].x), bflo(c4[cs][r].y) * bflo(h4[cs][r].y), bfhi(c4[cs][r].y) * bfhi(h4[cs][r].y)} * f; }
#pragma unroll
          for (int i = 0; i < 8; ++i) { const f32x4 gb = {bflo(g4[cs][i].x), bfhi(g4[cs][i].x), bflo(g4[cs][i].y), bfhi(g4[cs][i].y)};
              const f32x4 c = gb * (w0 * u[i] + w1 * u[i + 1] + w2 * u[i + 2]);
              const unsigned p0 = pk2(c[0], c[1]), p1 = pk2(c[2], c[3]); cpk[8 * bt + i][0] = p0; cpk[8 * bt + i][1] = p1;
              const float r0 = bflo(p0), r1 = bfhi(p0), r2 = bflo(p1), r3 = bfhi(p1);
              const float sq = wave_sum((r0 * r0 + r1 * r1) + (r2 * r2 + r3 * r3));
              if (lane == 0) CSSQ[(8 * bt + i) * 8 + wid] = sq; }
          asm volatile("" ::: "memory"); }
#undef CONV_LOAD
      LDS_WAIT(); __syncthreads();
      if (tid < 32) { float s = 0.f;
#pragma unroll
          for (int w = 0; w < 8; ++w) s += CSSQ[tid * 8 + w];
          CRS[tid] = 1.0f / sqrtf(s * (1.0f / 2048.0f) + EPS); }
      LDS_WAIT(); __syncthreads();
#pragma unroll
      for (int i = 0; i < 32; ++i) { const float rs = CRS[i]; v2u w; w.x = pk2(bflo(cpk[i][0]) * rs, bfhi(cpk[i][0]) * rs); w.y = pk2(bflo(cpk[i][1]) * rs, bfhi(cpk[i][1]) * rs);
          *(v2u*)(MRG + tiled_idx(rowbase + t0 + i, 2048 + ch, DM / 64)) = w; } }
}
#undef KSWZ
#undef SBAR
}

struct Args { const float* in[22]; float* out; unsigned char* ws; int ph_lo, ph_hi; };
__global__ void __launch_bounds__(NWAVES * 64, 2) mk_fwd(Args args) {
    extern __shared__ __attribute__((aligned(16))) unsigned char lds_raw[];
    LAS unsigned char* lds = (LAS unsigned char*)lds_raw;
    volatile LAS unsigned* MISC = (volatile LAS unsigned*)(lds + MISC_OFF);
    const int tid = threadIdx.x, lane = tid & 63, wave = __builtin_amdgcn_readfirstlane(tid >> 6), G = gridDim.x;
    unsigned char* ws = args.ws;
    gu32* ctl = (gu32*)(ws + WS_CTL);
    const float* x_prompt = args.in[0]; const float* x_sample = args.in[1]; const float* cvec = args.in[2]; const float* cache_k = args.in[3]; const float* cache_v = args.in[4];
    const float* c_ctx = args.in[5]; const float* w_mod = args.in[6]; const float* b_mod = args.in[7]; const float* g_pre = args.in[8]; const float* g_post = args.in[9];
    const float* w_in = args.in[10]; const float* w_conv = args.in[11]; const float* sink = args.in[12]; const float* g_attn = args.in[13]; const float* g_conv = args.in[14];
    const float* w_o = args.in[15]; const float* wg1 = args.in[16]; const float* wu1 = args.in[17]; const float* wd1 = args.in[18];
    const float* wg2 = args.in[19]; const float* wu2 = args.in[20]; const float* wd2 = args.in[21];
    float* out = args.out; float* state_k = out + (size_t)2 * NCTX * DM; float* state_v = state_k + (size_t)NCTX * 512;
    float* MOD = (float*)(ws + WS_MOD); float* ROPE = (float*)(ws + WS_ROPE); bf16* CK = (bf16*)(ws + WS_CK); bf16* CV = (bf16*)(ws + WS_CV);
    bf16* WGU1 = (bf16*)(ws + WS_WGU1); bf16* WD1 = (bf16*)(ws + WS_WD1); bf16* WIN = (bf16*)(ws + WS_WIN); bf16* WO = (bf16*)(ws + WS_WO); bf16* WGU2 = (bf16*)(ws + WS_WGU2); bf16* WD2 = (bf16*)(ws + WS_WD2);
    bf16* U = (bf16*)(ws + WS_U); bf16* MRG = (bf16*)(ws + WS_MRG); bf16* ACT = (bf16*)(ws + WS_ACT); bf16* Ob = (bf16*)(ws + WS_O); bf16* Hb = (bf16*)(ws + WS_H); bf16* Z = (bf16*)(ws + WS_Z);

    for (int u = tid; u < (LDS_BYTES - LDSCTL_OFF) / 4; u += NWAVES * 64) ((LAS unsigned*)(lds + LDSCTL_OFF))[u] = 0u;
    __syncthreads();
    XcdBarrier bar; bar.bar = (unsigned*)(ctl + CW_BAR); bar.x = 0; bar.st = nullptr;
    if (N_LAUNCHES != NPHASE) bar = xcd_barrier_post((unsigned*)(ctl + CW_BAR), MISC + 8);
#define GRID_BAR() do { if (N_LAUNCHES != NPHASE) xcd_barrier(bar); } while (0)
    const int lo = args.ph_lo, hi = args.ph_hi;
#define IN(k) (lo <= (k) && (k) < hi)
#define BOTH(k) (IN(k) && IN((k) + 1))
    const int gw = blockIdx.x * NWAVES + wave, NGW = G * NWAVES;
    const P0Args A{cvec, cache_k, cache_v, c_ctx, w_mod, b_mod, w_in, g_attn, g_conv, w_o, wg1, wu1, wd1, wg2, wu2, wd2, MOD, ROPE, CK, CV, WGU1, WD1, WIN, WO, WGU2, WD2, ws};

    if (IN(0)) {
        phase0(lds, A, tid, wave, lane, G);
        if (BOTH(0)) GRID_BAR();
    }
    if (IN(1)) {
        rows_pre(lds, x_prompt, x_sample, MOD, g_pre + 0 * DM, U, tid, wave, lane, G);
        if (BOTH(1)) GRID_BAR();
    }
    if (IN(2)) {
        pg8::Gemm g{U, WGU1, NTOK, 2 * DFF, DM}; pg8::StaticOrder S; S.init(NTOK, 2 * DFF, G, (int)blockIdx.x);
        pg8::EpiSwiGLU E{ACT, DFF / 64};
        pg8::gemm_phase<pg8::EpiSwiGLU, pg8::StaticOrder, true, true, true, true>(lds, g, S, E);
        tail_convert(lds, A, wave, lane, G, (NTOK / 256) * (2 * DFF / 256), CI_P0_END, CI_WD1_END);
        if (BOTH(2)) GRID_BAR();
    }
    if (IN(3)) {
        pg8::Gemm g{ACT, WD1, NTOK, DM, DFF}; pg8::HalfMOrder S; S.init(NTOK, DM, G, (int)blockIdx.x);
        pg8::EpiBf16 E{Ob, DM};
        pg8::gemm_phase<pg8::EpiBf16, pg8::HalfMOrder, true, true, true, true>(lds, g, S, E);
        if (BOTH(3)) GRID_BAR();
    }
    if (IN(4)) {
        rows_post_pre<true, true, 0>(lds, x_prompt, x_sample, Hb, Ob, MOD, 0.5f, g_post + 0 * DM, nullptr, g_pre + 1 * DM, U, tid, wave, lane, G);
        if (BOTH(4)) GRID_BAR();
    }
    if (IN(5)) {
        pg8::Gemm g{U, WIN, NTOK, INW, DM}; pg8::StaticOrder S; S.init(NTOK, INW, G, (int)blockIdx.x);
        pg8::EpiInProj E{Z, ROPE, state_k, state_v};
        pg8::gemm_phase<pg8::EpiInProj, pg8::StaticOrder, true, true, true, true>(lds, g, S, E);
        tail_convert(lds, A, wave, lane, G, (NTOK / 256) * (INW / 256), CI_WD1_END, CI_X1);
        if (BOTH(5)) GRID_BAR();
    }
    if (IN(6)) {
        for (int unit = blockIdx.x; unit < 256; unit += G) att::attn_conv_unit(lds, unit, Z, CK, CV, sink, w_conv, MRG, tid, wave, lane);
        if (G == 256) { if (blockIdx.x < 128) convert_items(lds, A, wave, lane, CI_X1, CI_X2, (int)blockIdx.x * NWAVES + wave, 128 * NWAVES); }
        else convert_items(lds, A, wave, lane, CI_X1, CI_X2, (int)blockIdx.x * NWAVES + wave, G * NWAVES);
        if (BOTH(6)) GRID_BAR();
    }
    if (IN(7)) {
        pg8::Gemm g{MRG, WO, NTOK, DM, DM}; pg8::StaticOrder S; S.init(NTOK, DM, G, (int)blockIdx.x);
        pg8::EpiBf16 E{Ob, DM};
        pg8::gemm_phase<pg8::EpiBf16, pg8::StaticOrder, true, true, true, true>(lds, g, S, E);
        if (BOTH(7)) GRID_BAR();
    }
    if (IN(8)) {
        rows_post_pre<true, false, 1>(lds, x_prompt, x_sample, Hb, Ob, MOD, 1.0f, g_post + 1 * DM, nullptr, g_pre + 2 * DM, U, tid, wave, lane, G);
        if (BOTH(8)) GRID_BAR();
    }
    if (IN(9)) {
        pg8::Gemm g{U, WGU2, NTOK, 2 * DFF, DM}; pg8::StaticOrder S; S.init(NTOK, 2 * DFF, G, (int)blockIdx.x);
        pg8::EpiSwiGLU E{ACT, DFF / 64};
        pg8::gemm_phase<pg8::EpiSwiGLU, pg8::StaticOrder, true, true, true, true>(lds, g, S, E);
        tail_convert(lds, A, wave, lane, G, (NTOK / 256) * (2 * DFF / 256), CI_X2, CI_END);
        if (BOTH(9)) GRID_BAR();
    }
    if (IN(10)) {
        pg8::Gemm g{ACT, WD2, NTOK, DM, DFF}; pg8::HalfMOrder S; S.init(NTOK, DM, G, (int)blockIdx.x);
        pg8::EpiBf16 E{Ob, DM};
        pg8::gemm_phase<pg8::EpiBf16, pg8::HalfMOrder, true, true, true, true>(lds, g, S, E);
        if (BOTH(10)) GRID_BAR();
    }
    if (IN(11)) {
        rows_post_pre<false, false, 2>(lds, x_prompt, x_sample, Hb, Ob, MOD, 0.5f, g_post + 2 * DM, out, nullptr, nullptr, tid, wave, lane, G);
    }
#undef IN
#undef BOTH
#undef GRID_BAR
}

extern "C" void kernel_launch(void* const* d_in, const int* in_sizes, int n_in, void* d_out, int out_size, void* d_ws, size_t ws_size, hipStream_t stream) {
    static int grid = 0;
    if (grid == 0) {
        if (n_in != 22 || ws_size < WS_END) { fprintf(stderr, "kernel_launch: expected 22 inputs and >= %zu bytes of workspace; got %d inputs, %zu bytes\n", (size_t)WS_END, n_in, ws_size); grid = -1; return; }
        int dev = 0, cus = 0, per_cu = 0;
        if (hipGetDevice(&dev) != hipSuccess || hipDeviceGetAttribute(&cus, hipDeviceAttributeMultiprocessorCount, dev) != hipSuccess) { fprintf(stderr, "kernel_launch: device query failed\n"); grid = -1; return; }
        if (hipFuncSetAttribute((const void*)mk_fwd, hipFuncAttributeMaxDynamicSharedMemorySize, LDS_BYTES) != hipSuccess) { fprintf(stderr, "kernel_launch: hipFuncSetAttribute failed\n"); grid = -1; return; }
        if (hipOccupancyMaxActiveBlocksPerMultiprocessor(&per_cu, (const void*)mk_fwd, NWAVES * 64, LDS_BYTES) != hipSuccess || per_cu < 1)
            fprintf(stderr, "kernel_launch: note: occupancy query reports %d workgroups per CU\n", per_cu);
        (void)hipGetLastError();
        grid = cus;
    }
    if (grid < 0) return;
    if (hipMemsetAsync((char*)d_ws + WS_CTL, 0, CTL_ZERO_BYTES, stream) != hipSuccess) { fprintf(stderr, "kernel_launch: memset failed\n"); return; }
    Args a{};
    for (int i = 0; i < 22; ++i) a.in[i] = (const float*)d_in[i];
    a.out = (float*)d_out; a.ws = (unsigned char*)d_ws;
    const int nl = (N_LAUNCHES == NPHASE) ? NPHASE : 1;
    for (int li = 0; li < nl; ++li) {
        a.ph_lo = (N_LAUNCHES == NPHASE) ? li : 0; a.ph_hi = (N_LAUNCHES == NPHASE) ? li + 1 : NPHASE;
        hipLaunchKernelGGL(mk_fwd, dim3(grid), dim3(NWAVES * 64), LDS_BYTES, stream, a);
        const hipError_t le = hipPeekAtLastError();
        if (le != hipSuccess) { fprintf(stderr, "kernel_launch: launch %d failed: %s\n", li, hipGetErrorName(le)); break; }
    }
}
```
